# Optimizing an MI355X kernel written in HIP

```python
import jax, jax.numpy as jnp
from jax import lax
import numpy as np

D_MODEL = 1024
BATCH = 8
SEQ = 4096
DEPTH = 1

N_MEM = 256
CONV_WIDTH = D_MODEL // 2
CONV_KERNEL = 31
RET_WIDTH = D_MODEL - CONV_WIDTH
RET_HEADS = 4
RET_HEAD_DIM = RET_WIDTH // RET_HEADS
RET_CHUNK = 128
ROPE_BASE = 10000.0
IN_COLS = 2 * CONV_WIDTH + 4 * RET_WIDTH
SPLITS = (CONV_WIDTH, 2 * CONV_WIDTH, 2 * CONV_WIDTH + RET_WIDTH,
          2 * CONV_WIDTH + 2 * RET_WIDTH, 2 * CONV_WIDTH + 3 * RET_WIDTH)
XATTN_HEADS = 4
XATTN_HEAD_DIM = D_MODEL // XATTN_HEADS
D_FF = 4 * D_MODEL
LN_EPS = 1e-5
DN_ALPHA = (2.0 * DEPTH) ** 0.25
DN_BETA = (8.0 * DEPTH) ** -0.25

kernel_name = "deepnorm_conformer_retention_hybrid"


def layer_norm(x, g, b):
    xf = x.astype(jnp.float32)
    mu = jnp.mean(xf, axis=-1, keepdims=True)
    var = jnp.mean(jnp.square(xf - mu), axis=-1, keepdims=True)
    y = (xf - mu) * lax.rsqrt(var + LN_EPS)
    return (y * g.astype(jnp.float32) + b.astype(jnp.float32)).astype(x.dtype)


def rotary(t, pos):
    half = t.shape[-1] // 2
    inv = ROPE_BASE ** (-jnp.linspace(0.0, 1.0, half, dtype=jnp.float32))
    ang = pos[:, None] * inv[None, :]
    cos = jnp.cos(ang)[None, :, None, :].astype(t.dtype)
    sin = jnp.sin(ang)[None, :, None, :].astype(t.dtype)
    t1, t2 = t[..., :half], t[..., half:]
    return jnp.concatenate([t1 * cos - t2 * sin, t2 * cos + t1 * sin], axis=-1)


def retention_chunkwise(q, k, v):
    B, S, H, d = q.shape
    C = RET_CHUNK
    n_chunks = S // C
    log_g = jnp.log(1.0 - 2.0 ** (-5.0 - jnp.arange(H, dtype=jnp.float32)))
    idx = jnp.arange(C, dtype=jnp.float32)
    rel = idx[:, None] - idx[None, :]
    decay = jnp.where(rel >= 0, jnp.exp(log_g[:, None, None] * jnp.maximum(rel, 0.0)), 0.0)
    q_dec = jnp.exp(log_g[:, None] * (idx + 1.0))
    k_dec = jnp.exp(log_g[:, None] * (C - 1.0 - idx))
    chunk_dec = jnp.exp(log_g * C)

    def to_chunks(t):
        return t.reshape(B, n_chunks, C, H, d).transpose(1, 0, 3, 2, 4)

    def step(state, qkv):
        qc, kc, vc = qkv
        scores = jnp.einsum('bhnd,bhmd->bhnm', qc, kc) * decay[None]
        intra = jnp.einsum('bhnm,bhmd->bhnd', scores, vc)
        cross = jnp.einsum('bhnd,bhde->bhne', qc * q_dec[None, :, :, None], state)
        new_state = state * chunk_dec[None, :, None, None] + jnp.einsum(
            'bhmd,bhme->bhde', kc * k_dec[None, :, :, None], vc)
        return new_state, intra + cross

    state0 = jnp.zeros((B, H, d, d), jnp.float32)
    _, out = lax.scan(step, state0, (to_chunks(q), to_chunks(k), to_chunks(v)))
    return out.transpose(1, 0, 3, 2, 4).reshape(B, S, H, d)


def hybrid_mixer(x, w_in, conv_w, conv_b, conv_ln_g, conv_ln_b, ret_gn_g, ret_gn_b, w_out):
    B, S, _ = x.shape
    h = x @ w_in
    a, b, q, k, v, g = jnp.split(h, SPLITS, axis=-1)
    u = a * jax.nn.sigmoid(b)
    u = lax.conv_general_dilated(
        u, conv_w[:, None, :].astype(u.dtype), window_strides=(1,),
        padding=[(CONV_KERNEL - 1, 0)], dimension_numbers=('NWC', 'WIO', 'NWC'),
        feature_group_count=CONV_WIDTH) + conv_b
    conv_out = jax.nn.silu(layer_norm(u, conv_ln_g, conv_ln_b))
    pos = jnp.arange(S, dtype=jnp.float32)
    q = rotary(q.reshape(B, S, RET_HEADS, RET_HEAD_DIM), pos) * (RET_HEAD_DIM ** -0.5)
    k = rotary(k.reshape(B, S, RET_HEADS, RET_HEAD_DIM), pos)
    v = v.reshape(B, S, RET_HEADS, RET_HEAD_DIM)
    y = retention_chunkwise(q.astype(jnp.float32), k.astype(jnp.float32), v.astype(jnp.float32))
    mu = jnp.mean(y, axis=-1, keepdims=True)
    var = jnp.mean(jnp.square(y - mu), axis=-1, keepdims=True)
    y = ((y - mu) * lax.rsqrt(var + LN_EPS)).reshape(B, S, RET_WIDTH)
    y = y * ret_gn_g.astype(jnp.float32) + ret_gn_b.astype(jnp.float32)
    ret_out = jax.nn.silu(g) * y.astype(x.dtype)
    return jnp.concatenate([conv_out, ret_out], axis=-1) @ w_out


def memory_cross_attention(x, mem, w_xq, w_xk, w_xv, w_xo):
    B, S, D = x.shape
    M = mem.shape[1]
    q = (x @ w_xq).reshape(B, S, XATTN_HEADS, XATTN_HEAD_DIM)
    k = (mem @ w_xk).reshape(B, M, XATTN_HEADS, XATTN_HEAD_DIM)
    v = (mem @ w_xv).reshape(B, M, XATTN_HEADS, XATTN_HEAD_DIM)
    s = jnp.einsum('bshd,bmhd->bhsm', q, k).astype(jnp.float32) * (XATTN_HEAD_DIM ** -0.5)
    p = jax.nn.softmax(s, axis=-1).astype(x.dtype)
    o = jnp.einsum('bhsm,bmhd->bshd', p, v).reshape(B, S, D)
    return o @ w_xo


def squared_relu_mlp(x, w_up, w_down):
    return jnp.square(jax.nn.relu(x @ w_up)) @ w_down


def setup_inputs(seed: int = 0) -> dict:
    key = jax.random.key(seed)
    ks = jax.random.split(key, 22)
    f32 = jnp.float32
    L, D = DEPTH, D_MODEL

    def dense(k, shape, fan_in, scale=1.0):
        return jax.random.normal(k, shape, f32) * (scale * fan_in ** -0.5)

    def gain(k, shape):
        return 1.0 + 0.02 * jax.random.normal(k, shape, f32)

    def bias(k, shape):
        return 0.02 * jax.random.normal(k, shape, f32)

    return {
        'x': jax.random.normal(ks[0], (BATCH, SEQ, D), f32),
        'mem': jax.random.normal(ks[1], (BATCH, N_MEM, D), f32),
        'w_in': dense(ks[2], (L, D, IN_COLS), D),
        'conv_w': dense(ks[3], (L, CONV_KERNEL, CONV_WIDTH), CONV_KERNEL),
        'conv_b': bias(ks[4], (L, CONV_WIDTH)),
        'conv_ln_g': gain(ks[5], (L, CONV_WIDTH)),
        'conv_ln_b': bias(ks[6], (L, CONV_WIDTH)),
        'ret_gn_g': gain(ks[7], (L, RET_WIDTH)),
        'ret_gn_b': bias(ks[8], (L, RET_WIDTH)),
        'w_out': dense(ks[9], (L, D, D), D, DN_BETA),
        'ln1_g': gain(ks[10], (L, D)),
        'ln1_b': bias(ks[11], (L, D)),
        'w_xq': dense(ks[12], (L, D, D), D),
        'w_xk': dense(ks[13], (L, D, D), D),
        'w_xv': dense(ks[14], (L, D, D), D, DN_BETA),
        'w_xo': dense(ks[15], (L, D, D), D, DN_BETA),
        'ln2_g': gain(ks[16], (L, D)),
        'ln2_b': bias(ks[17], (L, D)),
        'w_up': dense(ks[18], (L, D, D_FF), D, DN_BETA),
        'w_down': dense(ks[19], (L, D_FF, D), D_FF, DN_BETA),
        'ln3_g': gain(ks[20], (L, D)),
        'ln3_b': bias(ks[21], (L, D)),
    }


def reference(x, mem, w_in, conv_w, conv_b, conv_ln_g, conv_ln_b, ret_gn_g, ret_gn_b, w_out,
              ln1_g, ln1_b, w_xq, w_xk, w_xv, w_xo, ln2_g, ln2_b, w_up, w_down, ln3_g, ln3_b):
    for l in range(DEPTH):
        mix = hybrid_mixer(x, w_in[l], conv_w[l], conv_b[l], conv_ln_g[l], conv_ln_b[l],
                           ret_gn_g[l], ret_gn_b[l], w_out[l])
        x = layer_norm(DN_ALPHA * x + mix, ln1_g[l], ln1_b[l])
        xa = memory_cross_attention(x, mem, w_xq[l], w_xk[l], w_xv[l], w_xo[l])
        x = layer_norm(DN_ALPHA * x + xa, ln2_g[l], ln2_b[l])
        ff = squared_relu_mlp(x, w_up[l], w_down[l])
        x = layer_norm(DN_ALPHA * x + ff, ln3_g[l], ln3_b[l])
    return x
```

```cpp
#include <hip/hip_runtime.h>
#include <hip/hip_cooperative_groups.h>
#include <cstdio>
#include <cstdint>
namespace cg = cooperative_groups;
namespace pg8 {
#define PG8_LAS __attribute__((address_space(3)))
typedef unsigned short bf16_t;
typedef short bf16x8 __attribute__((ext_vector_type(8)));
typedef float f32x4 __attribute__((ext_vector_type(4)));
typedef unsigned u32x4 __attribute__((ext_vector_type(4)));
constexpr int BM = 256, BK = 64, HALF = 128, HTB = HALF * BK * 2  , STAGE_BYTES = 8 * HTB, NXCD = 8, WGM = 8;

__host__ __device__ __forceinline__ int lds_byte(int r, int c) { const int st = (r >> 4) * 2 + (c >> 5), rr = r & 15, cc = c & 31, ob = rr * 64 + cc * 2; return st * 1024 + (ob ^ (((ob >> 9) & 1) << 5)); }
__host__ __device__ __forceinline__ void stage_rc(int b, int& R, int& C) { const int st = b / 1024, sb = b % 1024, swz = sb ^ (((sb >> 9) & 1) << 5); R = (st >> 1) * 16 + swz / 64; C = (st & 1) * 32 + (swz % 64) / 2; }
__host__ __device__ __forceinline__ int perm32(int rho) { const int n = rho >> 4, i = rho & 15; return 8 * (i >> 2) + 4 * n + (i & 3); }

struct Unit { int pm, pn; };
struct Gemm { const bf16_t* A; const bf16_t* Bt; int M, N, K; };

struct StaticOrder {
    int nM, nN, nwg, G, c;
    __host__ __device__ void init(int M, int N, int G_, int c_) { nM = M / BM; nN = N / BM; nwg = nM * nN; G = G_; c = c_; }
    __host__ __device__ bool next(int i, Unit& u) const {
        const long L = (long)i * G + c; if (L >= nwg) return false;
        int wgid = (int)L; { const int q = nwg / NXCD, r = nwg % NXCD, xcd = wgid % NXCD, off = wgid / NXCD; wgid = (xcd < r ? xcd * (q + 1) : r * (q + 1) + (xcd - r) * q) + off; }
        const int nig = WGM * nN, gid = wgid / nig, fm = gid * WGM, gsz = (nM - fm) < WGM ? (nM - fm) : WGM;
        u.pm = fm + ((wgid % nig) % gsz); u.pn = (wgid % nig) / gsz; return true;
    }
    __device__ __forceinline__ void a_ready(const Unit&) const {}
    __device__ __forceinline__ void done(const Unit&) const {}
};

__device__ __forceinline__ unsigned cvt_pk_bf16(float lo, float hi) { unsigned r; asm volatile("v_cvt_pk_bf16_f32 %0, %1, %2" : "=v"(r) : "v"(lo), "v"(hi)); return r; }
typedef float f32x2 __attribute__((ext_vector_type(2)));
__device__ __forceinline__ f32x2 gelu_pk(f32x2 v) {
    const f32x2 av = __builtin_elementwise_abs(v), d = av * 0.2316418882f + 1.0f;
    f32x2 t; t.x = __builtin_amdgcn_rcpf(d.x); t.y = __builtin_amdgcn_rcpf(d.y);
    f32x2 q = t * 0.5307027145f + (-0.7265760135f); q = q * t + 0.7107068705f; q = q * t + (-0.142248368f); q = q * t + 0.127414796f; q = q * t;
    const f32x2 s = (v * v) * (-0.72134752044f);
    f32x2 e; e.x = __builtin_amdgcn_exp2f(s.x); e.y = __builtin_amdgcn_exp2f(s.y);
    const f32x2 m = v * (q * e), r = v - m;
    f32x2 o; o.x = v.x < 0.f ? m.x : r.x; o.y = v.y < 0.f ? m.y : r.y; return o;
}

template <int ACT  > struct EpiBf16 {
    static constexpr bool PERM = true, AFTER_DRAIN = false; static_assert(ACT == 0 || ACT == 1, "EpiBf16: ACT is 0 (none) or 1 (gelu_pk)");
    bf16_t* O; int ldc; const float* bias; int split_cols; size_t split_stride; float scale0;
    __device__ __forceinline__ void operator()(const f32x4 (&acc)[2][2][4][2], const Unit& u, int wr, int wc, int fr, int fq) const {
        const int row0 = u.pm * BM + wr * 64 + fr; int colt = u.pn * BM; bf16_t* base = O;
        float sc = 1.f; if (split_cols) { const int t = colt / split_cols; base += (size_t)t * split_stride; colt -= t * split_cols; if (t == 0) sc = scale0; }
        const int col0 = colt + wc * 32 + 8 * fq, bcol0 = u.pn * BM + wc * 32 + 8 * fq;
        f32x4 bv[2][2];
#pragma unroll
        for (int bj = 0; bj < 2; ++bj)
#pragma unroll
            for (int n = 0; n < 2; ++n) bv[bj][n] = bias ? *(const f32x4*)(bias + bcol0 + bj * HALF + 4 * n) : (f32x4){0.f, 0.f, 0.f, 0.f};
#pragma unroll
        for (int ai = 0; ai < 2; ++ai)
#pragma unroll
            for (int m = 0; m < 4; ++m) { bf16_t* rowp = base + (size_t)(row0 + ai * HALF + m * 16) * ldc + col0;
#pragma unroll
                for (int bj = 0; bj < 2; ++bj) { f32x4 v0 = acc[ai][bj][m][0] + bv[bj][0], v1 = acc[ai][bj][m][1] + bv[bj][1];
                    if (ACT == 1) { f32x2 a = gelu_pk((f32x2){v0[0], v0[1]}), b = gelu_pk((f32x2){v0[2], v0[3]}), c = gelu_pk((f32x2){v1[0], v1[1]}), d = gelu_pk((f32x2){v1[2], v1[3]});
                        v0 = (f32x4){a.x, a.y, b.x, b.y}; v1 = (f32x4){c.x, c.y, d.x, d.y}; }
                    v0 = v0 * sc; v1 = v1 * sc; u32x4 w; w.x = cvt_pk_bf16(v0[0], v0[1]); w.y = cvt_pk_bf16(v0[2], v0[3]); w.z = cvt_pk_bf16(v1[0], v1[1]); w.w = cvt_pk_bf16(v1[2], v1[3]);
                    *(u32x4*)(rowp + bj * HALF) = w; } }
    }
};
template <int ACT  > struct EpiStoreBf16 {
    static constexpr bool PERM = true, AFTER_DRAIN = false;
    bf16_t* O; int ldc;
    __device__ __forceinline__ void operator()(const f32x4 (&acc)[2][2][4][2], const Unit& u, int wr, int wc, int fr, int fq) const {
        const int row0 = u.pm * BM + wr * 64 + fr; const int col0 = u.pn * BM + wc * 32 + 8 * fq;
#pragma unroll
        for (int ai = 0; ai < 2; ++ai)
#pragma unroll
            for (int m = 0; m < 4; ++m) { bf16_t* rowp = O + (size_t)(row0 + ai * HALF + m * 16) * ldc + col0;
#pragma unroll
                for (int bj = 0; bj < 2; ++bj) { f32x4 v0 = acc[ai][bj][m][0], v1 = acc[ai][bj][m][1];
                    if (ACT == 1) {
#pragma unroll
                        for (int e = 0; e < 4; ++e) { const float a = fmaxf(v0[e], 0.f), b = fmaxf(v1[e], 0.f); v0[e] = a * a; v1[e] = b * b; } }
                    u32x4 w; w.x = cvt_pk_bf16(v0[0], v0[1]); w.y = cvt_pk_bf16(v0[2], v0[3]); w.z = cvt_pk_bf16(v1[0], v1[1]); w.w = cvt_pk_bf16(v1[2], v1[3]);
                    *(u32x4*)(rowp + bj * HALF) = w; } }
    }
};
struct EpiResF32 {
    static constexpr bool PERM = false, AFTER_DRAIN = false;
    const float* base; float* out; int ldc; float alpha;
    __device__ __forceinline__ void operator()(const f32x4 (&acc)[2][2][4][2], const Unit& u, int wr, int wc, int fr, int fq) const {
        const int col0 = u.pn * BM + wc * 32 + 4 * fq;
#pragma unroll
        for (int ai = 0; ai < 2; ++ai)
#pragma unroll
            for (int m = 0; m < 4; ++m) { const size_t off = (size_t)(u.pm * BM + ai * HALF + wr * 64 + m * 16 + fr) * ldc + col0;
#pragma unroll
                for (int bj = 0; bj < 2; ++bj)
#pragma unroll
                    for (int n = 0; n < 2; ++n) { const f32x4 bs = *(const f32x4*)(base + off + bj * HALF + n * 16); const f32x4 o = bs * alpha + acc[ai][bj][m][n];
                        *(f32x4*)(out + off + bj * HALF + n * 16) = o; } }
    }
};
template <class Epi, class Sched, bool ALIGN_EPI = false, bool SP2 = false>
__device__ __forceinline__ void gemm_phase(PG8_LAS unsigned char* lds, const Gemm g, const Sched& S, const Epi& E) {
    const int tid = threadIdx.x, wid = __builtin_amdgcn_readfirstlane(tid >> 6), lane = tid & 63, wr = wid >> 2, wc = wid & 3, fr = lane & 15, fq = lane >> 4;
    const int K = g.K, nt = K / BK;
    unsigned voffA[2], voffB[2];
#pragma unroll
    for (int i = 0; i < 2; ++i) { int R, C; stage_rc(tid * 16 + i * 8192, R, C); const int Rb = Epi::PERM ? ((R & ~31) + perm32(R & 31)) : R;
        voffA[i] = (unsigned)(R * K + C) * 2u; voffB[i] = (unsigned)(Rb * K + C) * 2u; }
    const size_t kstep = (size_t)(BK * 2);
    const size_t hstep = (size_t)HALF * K * 2;
    const size_t tstep = 2 * hstep;
    const unsigned ldsw = (unsigned)wid * 1024u;
    const int aoff = lds_byte(wr * 64 + fr, fq * 8), boff = lds_byte(wc * 32 + fr, fq * 8);
#define PG8_SA(b, h) (((b) * 2 + (h)) * HTB)
#define PG8_SB(b, h) ((4 + (b) * 2 + (h)) * HTB)
#define PG8_STAGE(bufoff, gbase, voff) do { _Pragma("unroll") for (int _i = 0; _i < 2; ++_i) \
        __builtin_amdgcn_global_load_lds((const unsigned*)((const char*)(gbase) + (voff)[_i]), (PG8_LAS unsigned*)(lds + (bufoff) + ldsw + _i * 8192), 16, 0, 0); } while (0)
#define PG8_LDA(dst, b, h) do { _Pragma("unroll") for (int m = 0; m < 4; ++m) _Pragma("unroll") for (int k = 0; k < 2; ++k) dst[m][k] = *(const PG8_LAS bf16x8*)(lds + PG8_SA(b, h) + aoff + m * 2048 + k * 1024); } while (0)
#define PG8_LDB(dst, b, h) do { _Pragma("unroll") for (int n = 0; n < 2; ++n) _Pragma("unroll") for (int k = 0; k < 2; ++k) dst[n][k] = *(const PG8_LAS bf16x8*)(lds + PG8_SB(b, h) + boff + n * 2048 + k * 1024); } while (0)
#define PG8_MMA(ai, bj, At, Bt) do { __builtin_amdgcn_s_setprio(1); _Pragma("unroll") for (int m = 0; m < 4; ++m) _Pragma("unroll") for (int n = 0; n < 2; ++n) _Pragma("unroll") for (int k = 0; k < 2; ++k) \
        acc[ai][bj][m][n] = __builtin_amdgcn_mfma_f32_16x16x32_bf16(Bt[n][k], At[m][k], acc[ai][bj][m][n], 0, 0, 0); __builtin_amdgcn_s_setprio(0); } while (0)
#define PG8_WAIT_V(n) asm volatile("s_waitcnt vmcnt(" #n ")" ::: "memory")
#define PG8_WAIT_L(n) asm volatile("s_waitcnt lgkmcnt(" #n ")" ::: "memory")
#define PG8_BAR __builtin_amdgcn_s_barrier()
#define PG8_SCHED __builtin_amdgcn_sched_barrier(0)
    Unit cur, nxt; int ui = 0;
    if (!S.next(0, cur)) return;
    f32x4 acc[2][2][4][2];
#pragma unroll
    for (int a = 0; a < 2; ++a)
#pragma unroll
        for (int b = 0; b < 2; ++b)
#pragma unroll
            for (int m = 0; m < 4; ++m)
#pragma unroll
                for (int n = 0; n < 2; ++n) acc[a][b][m][n] = (f32x4){0.f, 0.f, 0.f, 0.f};
    bf16x8 At[4][2], B0[2][2], B1[2][2];
    const char* cA = (const char*)g.A + (size_t)cur.pm * tstep; const char* cB = (const char*)g.Bt + (size_t)cur.pn * tstep;
    S.a_ready(cur);
    if constexpr (SP2) {
        PG8_STAGE(PG8_SB(0, 0), cB, voffB); PG8_STAGE(PG8_SB(0, 1), cB + hstep, voffB); PG8_STAGE(PG8_SA(0, 0), cA, voffA); PG8_STAGE(PG8_SA(0, 1), cA + hstep, voffA);
        if (wr == 1) PG8_BAR;
        PG8_WAIT_V(2); PG8_BAR;
        PG8_STAGE(PG8_SB(1, 0), cB + kstep, voffB); PG8_STAGE(PG8_SA(1, 0), cA + kstep, voffA); PG8_STAGE(PG8_SB(1, 1), cB + hstep + kstep, voffB);
        PG8_WAIT_V(6); PG8_BAR;
    } else {
        PG8_STAGE(PG8_SB(0, 0), cB, voffB); PG8_STAGE(PG8_SA(0, 0), cA, voffA); PG8_STAGE(PG8_SB(0, 1), cB + hstep, voffB); PG8_STAGE(PG8_SA(0, 1), cA + hstep, voffA);
        if (wr == 1) PG8_BAR;
        PG8_WAIT_V(4); PG8_BAR;
        PG8_STAGE(PG8_SB(1, 0), cB + kstep, voffB); PG8_STAGE(PG8_SA(1, 0), cA + kstep, voffA); PG8_STAGE(PG8_SB(1, 1), cB + hstep + kstep, voffB);
        PG8_WAIT_V(6); PG8_BAR;
    }
    for (;;) {
        const bool has_next = S.next(ui + 1, nxt);
        const char* nA = has_next ? (const char*)g.A + (size_t)nxt.pm * tstep : cA; const char* nB = has_next ? (const char*)g.Bt + (size_t)nxt.pn * tstep : cB;
        for (int t = 0; t < nt; t += 2) {
            const bool last = (t == nt - 2);
            const char* a1 = cA + (size_t)(t + 1) * kstep;
            const char* a2 = last ? nA : cA + (size_t)(t + 2) * kstep; const char* b2 = last ? nB : cB + (size_t)(t + 2) * kstep;
            const char* a3 = a2 + kstep; const char* b3 = b2 + kstep;
            if (last && has_next) S.a_ready(nxt);
            if constexpr (SP2) {
            PG8_LDB(B0, 0, 0); PG8_LDB(B1, 0, 1); PG8_SCHED; PG8_LDA(At, 0, 0); PG8_STAGE(PG8_SA(1, 1), a1 + hstep, voffA);
            PG8_WAIT_V(8); PG8_WAIT_L(0); PG8_BAR; PG8_MMA(0, 0, At, B0); PG8_MMA(0, 1, At, B1); PG8_BAR; PG8_SCHED;
            PG8_LDA(At, 0, 1); PG8_STAGE(PG8_SB(0, 0), b2, voffB); PG8_STAGE(PG8_SB(0, 1), b2 + hstep, voffB); PG8_STAGE(PG8_SA(0, 0), a2, voffA);
            PG8_WAIT_V(8); PG8_WAIT_L(0); PG8_BAR; PG8_MMA(1, 0, At, B0); PG8_MMA(1, 1, At, B1); PG8_BAR; PG8_SCHED;
            PG8_LDB(B0, 1, 0); PG8_LDB(B1, 1, 1); PG8_SCHED; PG8_LDA(At, 1, 0); PG8_STAGE(PG8_SA(0, 1), a2 + hstep, voffA);
            PG8_WAIT_V(8); PG8_WAIT_L(0); PG8_BAR; PG8_MMA(0, 0, At, B0); PG8_MMA(0, 1, At, B1); PG8_BAR; PG8_SCHED;
            PG8_LDA(At, 1, 1); PG8_STAGE(PG8_SB(1, 0), b3, voffB); PG8_STAGE(PG8_SB(1, 1), b3 + hstep, voffB); PG8_STAGE(PG8_SA(1, 0), a3, voffA);
            PG8_WAIT_V(8); PG8_WAIT_L(0); PG8_BAR; PG8_MMA(1, 0, At, B0); PG8_MMA(1, 1, At, B1); PG8_BAR; PG8_SCHED;
            } else {
            PG8_LDB(B0, 0, 0); PG8_SCHED; PG8_LDA(At, 0, 0); PG8_STAGE(PG8_SA(1, 1), a1 + hstep, voffA);
            PG8_WAIT_L(8); PG8_BAR; PG8_WAIT_L(0); PG8_MMA(0, 0, At, B0); PG8_BAR; PG8_SCHED;
            PG8_LDB(B1, 0, 1); PG8_STAGE(PG8_SB(0, 0), b2, voffB);
            PG8_BAR; PG8_WAIT_L(0); PG8_MMA(0, 1, At, B1); PG8_BAR;
            PG8_LDA(At, 0, 1); PG8_STAGE(PG8_SA(0, 0), a2, voffA);
            PG8_BAR; PG8_WAIT_L(0); PG8_MMA(1, 0, At, B0); PG8_BAR; PG8_SCHED;
            PG8_STAGE(PG8_SB(0, 1), b2 + hstep, voffB);
            PG8_WAIT_V(6); PG8_BAR; PG8_MMA(1, 1, At, B1); PG8_BAR;
            PG8_LDB(B0, 1, 0); PG8_SCHED; PG8_LDA(At, 1, 0); PG8_STAGE(PG8_SA(0, 1), a2 + hstep, voffA);
            PG8_WAIT_L(8); PG8_BAR; PG8_WAIT_L(0); PG8_MMA(0, 0, At, B0); PG8_BAR; PG8_SCHED;
            PG8_LDB(B1, 1, 1); PG8_STAGE(PG8_SB(1, 0), b3, voffB);
            PG8_BAR; PG8_WAIT_L(0); PG8_MMA(0, 1, At, B1); PG8_BAR;
            PG8_LDA(At, 1, 1); PG8_STAGE(PG8_SA(1, 0), a3, voffA);
            PG8_BAR; PG8_WAIT_L(0); PG8_MMA(1, 0, At, B0); PG8_BAR; PG8_SCHED;
            PG8_STAGE(PG8_SB(1, 1), b3 + hstep, voffB);
            PG8_WAIT_V(6); PG8_BAR; PG8_MMA(1, 1, At, B1); PG8_BAR;
            }
        }
        if constexpr (ALIGN_EPI) { if (wr == 0) PG8_BAR; }
        if constexpr (!Epi::AFTER_DRAIN) { E(acc, cur, wr, wc, fr, fq); S.done(cur); }
        if (!has_next) break;
#pragma unroll
        for (int a = 0; a < 2; ++a)
#pragma unroll
            for (int b = 0; b < 2; ++b)
#pragma unroll
                for (int m = 0; m < 4; ++m)
#pragma unroll
                    for (int n = 0; n < 2; ++n) acc[a][b][m][n] = (f32x4){0.f, 0.f, 0.f, 0.f};
        cur = nxt; cA = nA; cB = nB; ++ui;
        if constexpr (ALIGN_EPI) { if (wr == 1) PG8_BAR; }
    }
    PG8_WAIT_V(0);
    if constexpr (!ALIGN_EPI) { if (wr == 0) PG8_BAR; }
    PG8_BAR;
    if constexpr (Epi::AFTER_DRAIN) { E.fused(acc, cur, wr, wc, fr, fq, lds, wid, lane); S.done(cur); }
#undef PG8_SA
#undef PG8_SB
#undef PG8_STAGE
#undef PG8_LDA
#undef PG8_LDB
#undef PG8_MMA
#undef PG8_WAIT_V
#undef PG8_WAIT_L
#undef PG8_BAR
#undef PG8_SCHED
}
}

constexpr int NB = 8, SEQ = 4096, DM = 1024, T = NB * SEQ, NMEM = 256, MEMT = NB * NMEM;
constexpr int CW = 512, CKW = 31, RH = 4, RD = 128, RC = 128, NCH = SEQ / RC, INC = 3072;
constexpr int COL_A = 0, COL_B = 512, COL_Q = 1024, COL_K = 1536, COL_V = 2048, COL_G = 2560;
constexpr int XH = 4, XD = 256, FF = 4096;
constexpr float LN_EPS = 1e-5f;
constexpr float DN_ALPHA = 1.189207115002721f;
constexpr int NPHASE = 14;

constexpr size_t MiB = 1u << 20;
constexpr size_t WS_ROPE = 2 * MiB;
constexpr size_t WS_WIN = 8 * MiB, WS_WOUT = 14 * MiB, WS_WXQ = 16 * MiB, WS_WXK = 18 * MiB, WS_WXV = 20 * MiB, WS_WXO = 22 * MiB, WS_WUP = 24 * MiB, WS_WDN = 32 * MiB;
constexpr size_t WS_MEMB = 40 * MiB, WS_KM = 44 * MiB, WS_VT = 48 * MiB;
constexpr size_t WS_XB = 64 * MiB;
constexpr size_t WS_CAT = 128 * MiB;
constexpr size_t WS_H = 192 * MiB;
constexpr size_t WS_KV = 384 * MiB;
constexpr size_t WS_SBF = 448 * MiB;
constexpr size_t WS_HID = 192 * MiB;
constexpr size_t WS_END = 480 * MiB;

constexpr int LDS_BYTES = 147456;
constexpr int NWAVES = 8;

#define GAS __attribute__((address_space(1)))
#define LAS __attribute__((address_space(3)))
typedef unsigned short bf16;
typedef unsigned v4u __attribute__((ext_vector_type(4)));
typedef unsigned v2u __attribute__((ext_vector_type(2)));
typedef float f32x4 __attribute__((ext_vector_type(4)));
typedef short bf16x8 __attribute__((ext_vector_type(8)));
typedef short s16x4 __attribute__((ext_vector_type(4)));
#define LDS_WAIT() asm volatile("s_waitcnt lgkmcnt(0)" ::: "memory")

__device__ __forceinline__ unsigned f2bf(float f) { unsigned u = __builtin_bit_cast(unsigned, f); return (u + 0x7fffu + ((u >> 16) & 1u)) >> 16; }
__device__ __forceinline__ unsigned pk2(float lo, float hi) { return f2bf(lo) | (f2bf(hi) << 16); }
__device__ __forceinline__ float bflo(unsigned w) { return __builtin_bit_cast(float, w << 16); }
__device__ __forceinline__ float bfhi(unsigned w) { return __builtin_bit_cast(float, w & 0xffff0000u); }
__device__ __forceinline__ float bf1(bf16 b) { return __builtin_bit_cast(float, (unsigned)b << 16); }
__device__ __forceinline__ float wave_sum(float v) {
#pragma unroll
    for (int o = 1; o < 64; o <<= 1) v += __shfl_xor(v, o);
    return v;
}
__device__ __forceinline__ float sigmoidf_(float v) { return 1.0f / (1.0f + __expf(-v)); }

static __device__ const float ROPE_INV[64] = {
1.000000000e+00f, 8.639884591e-01f, 7.464760542e-01f, 6.449466348e-01f, 5.572264791e-01f, 4.814372361e-01f, 4.159561992e-01f, 3.593813479e-01f, 3.105013072e-01f, 2.682695389e-01f, 2.317818105e-01f, 2.002568096e-01f, 1.730195731e-01f, 1.494868994e-01f, 1.291549653e-01f, 1.115883961e-01f, 9.641107172e-02f, 8.329805732e-02f, 7.196855545e-02f, 6.218000501e-02f, 5.372280627e-02f, 4.641588405e-02f, 4.010278732e-02f, 3.464834765e-02f, 2.993577160e-02f, 2.586415969e-02f, 2.234633639e-02f, 1.930697635e-02f, 1.668100432e-02f, 1.441219542e-02f, 1.245197095e-02f, 1.075835899e-02f, 9.295094758e-03f, 8.030855097e-03f, 6.938565988e-03f, 5.994841456e-03f, 5.179473665e-03f, 4.475004971e-03f, 3.866352839e-03f, 3.340484342e-03f, 2.886140021e-03f, 2.493591513e-03f, 2.154434333e-03f, 1.861406374e-03f, 1.608233550e-03f, 1.389495214e-03f, 1.200507861e-03f, 1.037224894e-03f, 8.961503627e-04f, 7.742635789e-04f, 6.689548027e-04f, 5.779691855e-04f, 4.993587499e-04f, 4.314401885e-04f, 3.727593576e-04f, 3.220597864e-04f, 2.782559022e-04f, 2.404099068e-04f, 2.077113895e-04f, 1.794602285e-04f, 1.550515735e-04f, 1.339627779e-04f, 1.157422885e-04f, 9.999999747e-05f };

struct Args {
    const float* in[22]; float* out; unsigned char* ws; int ph_lo, ph_hi;
};

__device__ __forceinline__ void p0_transpose_item(const float* W, int K, int N, bf16* WT, LAS float* scr, int item, int lane) {
    const int nblk = N / 32, kb = item / nblk, nb = item % nblk, k0 = 64 * kb, n0 = 32 * nb;
#pragma unroll 8
    for (int i = 0; i < 32; ++i) { const int kk = 2 * i + (lane >> 5); scr[kk * 33 + (lane & 31)] = W[(size_t)(k0 + kk) * N + n0 + (lane & 31)]; }
    LDS_WAIT(); asm volatile("" ::: "memory");
    const int c = lane & 7;
#pragma unroll
    for (int j = 0; j < 4; ++j) { const int n = (lane >> 3) + 8 * j; const LAS float* s = scr + (8 * c) * 33 + n;
        v4u o; o.x = pk2(s[0 * 33], s[1 * 33]); o.y = pk2(s[2 * 33], s[3 * 33]); o.z = pk2(s[4 * 33], s[5 * 33]); o.w = pk2(s[6 * 33], s[7 * 33]);
        *(v4u*)(WT + (size_t)(n0 + n) * K + k0 + 8 * c) = o; }
    LDS_WAIT(); asm volatile("" ::: "memory");
}
__device__ __forceinline__ void cvt_rows(const float* src, bf16* dst, int n8, int gt, int NT) {
    for (int i = gt; i < n8; i += NT) {
        const f32x4 a = *(const f32x4*)(src + (size_t)i * 8), b = *(const f32x4*)(src + (size_t)i * 8 + 4);
        v4u o; o.x = pk2(a.x, a.y); o.y = pk2(a.z, a.w); o.z = pk2(b.x, b.y); o.w = pk2(b.z, b.w);
        *(v4u*)(dst + (size_t)i * 8) = o; }
}
__device__ __forceinline__ void p0_prologue(const Args& A, LAS unsigned char* lds, int vcu, int G, int tid, int wave, int lane) {
    unsigned char* ws = A.ws;
    LAS float* scr = (LAS float*)(lds + wave * 16384);
    const int gw = vcu * NWAVES + wave, NGW = G * NWAVES;
    constexpr int I_IN = 16 * 96, I_SQ = 16 * 32, I_UP = 16 * 128, I_DN = 64 * 32;
    constexpr int NITEMS = I_IN + 5 * I_SQ + I_UP + I_DN;
    for (int it = gw; it < NITEMS; it += NGW) {
        int r = it;
        if (r < I_IN) { p0_transpose_item(A.in[2], 1024, 3072, (bf16*)(ws + WS_WIN), scr, r, lane); continue; } r -= I_IN;
        if (r < I_SQ) { p0_transpose_item(A.in[9], 1024, 1024, (bf16*)(ws + WS_WOUT), scr, r, lane); continue; } r -= I_SQ;
        if (r < I_SQ) { p0_transpose_item(A.in[12], 1024, 1024, (bf16*)(ws + WS_WXQ), scr, r, lane); continue; } r -= I_SQ;
        if (r < I_SQ) { p0_transpose_item(A.in[13], 1024, 1024, (bf16*)(ws + WS_WXK), scr, r, lane); continue; } r -= I_SQ;
        if (r < I_SQ) { p0_transpose_item(A.in[14], 1024, 1024, (bf16*)(ws + WS_WXV), scr, r, lane); continue; } r -= I_SQ;
        if (r < I_SQ) { p0_transpose_item(A.in[15], 1024, 1024, (bf16*)(ws + WS_WXO), scr, r, lane); continue; } r -= I_SQ;
        if (r < I_UP) { p0_transpose_item(A.in[18], 1024, 4096, (bf16*)(ws + WS_WUP), scr, r, lane); continue; } r -= I_UP;
        p0_transpose_item(A.in[19], 4096, 1024, (bf16*)(ws + WS_WDN), scr, r, lane);
    }
    const int gt = vcu * 512 + tid, NT = G * 512;
    cvt_rows(A.in[0], (bf16*)(ws + WS_XB), T * DM / 8, gt, NT);
    cvt_rows(A.in[1], (bf16*)(ws + WS_MEMB), MEMT * DM / 8, gt, NT);
    float* cosT = (float*)(ws + WS_ROPE); float* sinT = cosT + SEQ * 64;
    for (int i = gt; i < SEQ * 64; i += NT) {
        const int pos = i >> 6, j = i & 63;
        const float ang = (float)pos * ROPE_INV[j];
        const double a = (double)ang; const double kq = rint(a * 0.63661977236758134308);
        const double r = a - kq * 1.57079632679489661923; const double r2 = r * r;
        double s = -2.5052108385441718775e-08; s = s * r2 + 2.7557319223985890653e-06; s = s * r2 - 1.9841269841269841270e-04; s = s * r2 + 8.3333333333333333333e-03; s = s * r2 - 1.6666666666666666667e-01; s = s * r2 * r + r;
        double c = 2.0876756987868098979e-09; c = c * r2 - 2.7557319223985890653e-07; c = c * r2 + 2.4801587301587301587e-05; c = c * r2 - 1.3888888888888888889e-03; c = c * r2 + 4.1666666666666666667e-02; c = c * r2 - 0.5; c = c * r2 + 1.0;
        const int q = ((int)kq) & 3;
        const double sv = (q == 0) ? s : (q == 1) ? c : (q == 2) ? -s : -c;
        const double cv = (q == 0) ? c : (q == 1) ? -s : (q == 2) ? -c : s;
        cosT[i] = (float)cv; sinT[i] = (float)sv;
    }
}

__device__ __forceinline__ void ln_phase(float* io, const float* g, const float* b, bf16* ob, int vcu, int G, int wave, int lane) {
    const int gw = vcu * NWAVES + wave, NGW = G * NWAVES;
    f32x4 gv[4], bv[4];
#pragma unroll
    for (int j = 0; j < 4; ++j) { gv[j] = *(const f32x4*)(g + 4 * (lane + 64 * j)); bv[j] = *(const f32x4*)(b + 4 * (lane + 64 * j)); }
    for (int m = gw; m < T; m += NGW) {
        f32x4* xr = (f32x4*)(io + (size_t)m * DM) + lane;
        f32x4 v[4]; float s = 0.f;
#pragma unroll
        for (int j = 0; j < 4; ++j) { v[j] = xr[64 * j]; s += (v[j].x + v[j].y) + (v[j].z + v[j].w); }
        const float mean = wave_sum(s) * (1.f / DM); float s2 = 0.f;
#pragma unroll
        for (int j = 0; j < 4; ++j) { v[j] = v[j] - mean; s2 += (v[j].x * v[j].x + v[j].y * v[j].y) + (v[j].z * v[j].z + v[j].w * v[j].w); }
        const float rstd = 1.f / sqrtf(wave_sum(s2) * (1.f / DM) + LN_EPS);
#pragma unroll
        for (int j = 0; j < 4; ++j) { v[j] = v[j] * rstd * gv[j] + bv[j]; xr[64 * j] = v[j]; }
        if (ob) { unsigned long long* o8 = (unsigned long long*)(ob + (size_t)m * DM) + lane;
#pragma unroll
            for (int j = 0; j < 4; ++j) o8[64 * j] = (unsigned long long)pk2(v[j].x, v[j].y) | ((unsigned long long)pk2(v[j].z, v[j].w) << 32); }
    }
}

__device__ __forceinline__ void conv_phase(const Args& A, LAS unsigned char* lds, int vcu, int G, int tid, int wave, int lane) {
    const bf16* h = (const bf16*)(A.ws + WS_H); bf16* cat = (bf16*)(A.ws + WS_CAT);
    const float* conv_w = A.in[3]; const int c = tid;
    float w[CKW];
#pragma unroll
    for (int j = 0; j < CKW; ++j) w[j] = conv_w[j * CW + c];
    const float bias = A.in[4][c];
    LAS float* ybuf = (LAS float*)lds;
    f32x4 g0 = *(const f32x4*)(A.in[5] + 8 * lane), g1 = *(const f32x4*)(A.in[5] + 8 * lane + 4);
    f32x4 b0 = *(const f32x4*)(A.in[6] + 8 * lane), b1 = *(const f32x4*)(A.in[6] + 8 * lane + 4);
    for (int unit = vcu; unit < NB * (SEQ / 32); unit += G) {
        const int b = unit / (SEQ / 32), t0 = (unit % (SEQ / 32)) * 32;
        float u[62];
        const bf16* hp = h + ((long)b * SEQ + t0 - 30) * (long)INC + c;
#pragma unroll
        for (int i = 0; i < 62; ++i) {
            if (t0 - 30 + i >= 0) { const float a = bf1(hp[(long)i * INC + COL_A]), bb = bf1(hp[(long)i * INC + COL_B]); u[i] = a * sigmoidf_(bb); }
            else u[i] = 0.f;
        }
#pragma unroll
        for (int tt = 0; tt < 32; ++tt) { float y = bias;
#pragma unroll
            for (int j = 0; j < CKW; ++j) y += w[j] * u[tt + j];
            ybuf[tt * CW + c] = y; }
        __syncthreads();
#pragma unroll
        for (int k = 0; k < 4; ++k) { const int tt = 4 * wave + k;
            const LAS f32x4* yr = (const LAS f32x4*)(ybuf + tt * CW) + 2 * lane;
            f32x4 v0 = yr[0], v1 = yr[1];
            const float mean = wave_sum((v0.x + v0.y) + (v0.z + v0.w) + (v1.x + v1.y) + (v1.z + v1.w)) * (1.f / CW);
            v0 = v0 - mean; v1 = v1 - mean;
            const float var = wave_sum((v0.x * v0.x + v0.y * v0.y) + (v0.z * v0.z + v0.w * v0.w) + (v1.x * v1.x + v1.y * v1.y) + (v1.z * v1.z + v1.w * v1.w)) * (1.f / CW);
            const float rstd = 1.f / sqrtf(var + LN_EPS);
            v0 = v0 * rstd * g0 + b0; v1 = v1 * rstd * g1 + b1;
#pragma unroll
            for (int e = 0; e < 4; ++e) { v0[e] = v0[e] * sigmoidf_(v0[e]); v1[e] = v1[e] * sigmoidf_(v1[e]); }
            v4u o; o.x = pk2(v0.x, v0.y); o.y = pk2(v0.z, v0.w); o.z = pk2(v1.x, v1.y); o.w = pk2(v1.z, v1.w);
            *(v4u*)(cat + ((size_t)b * SEQ + t0 + tt) * DM + 8 * lane) = o; }
        __syncthreads();
    }
}

constexpr int RP = 136;
template <bool TRANSPOSED, bool KDEC>
__device__ __forceinline__ void stage_rot(const bf16* h, size_t row0, int col0, int pos0, const float* cosT, const float* sinT, float sc, float lg2, LAS bf16* dst, int tid) {
#pragma unroll
    for (int k = 0; k < 2; ++k) {
        const int item = tid + 512 * k; const int m = item & 127, i = item >> 7;
        const bf16* hp = h + (row0 + m) * INC + col0 + 8 * i;
        const v4u k1 = *(const v4u*)hp, k2 = *(const v4u*)(hp + 64);
        const float* cp = cosT + (size_t)(pos0 + m) * 64 + 8 * i; const float* sp = sinT + (size_t)(pos0 + m) * 64 + 8 * i;
        const f32x4 c0 = *(const f32x4*)cp, c1 = *(const f32x4*)(cp + 4), s0 = *(const f32x4*)sp, s1 = *(const f32x4*)(sp + 4);
        float a[8], bq[8], cs[8], sn[8];
        a[0] = bflo(k1.x); a[1] = bfhi(k1.x); a[2] = bflo(k1.y); a[3] = bfhi(k1.y); a[4] = bflo(k1.z); a[5] = bfhi(k1.z); a[6] = bflo(k1.w); a[7] = bfhi(k1.w);
        bq[0] = bflo(k2.x); bq[1] = bfhi(k2.x); bq[2] = bflo(k2.y); bq[3] = bfhi(k2.y); bq[4] = bflo(k2.z); bq[5] = bfhi(k2.z); bq[6] = bflo(k2.w); bq[7] = bfhi(k2.w);
        cs[0] = c0.x; cs[1] = c0.y; cs[2] = c0.z; cs[3] = c0.w; cs[4] = c1.x; cs[5] = c1.y; cs[6] = c1.z; cs[7] = c1.w;
        sn[0] = s0.x; sn[1] = s0.y; sn[2] = s0.z; sn[3] = s0.w; sn[4] = s1.x; sn[5] = s1.y; sn[6] = s1.z; sn[7] = s1.w;
        float scl = sc; if (KDEC) scl *= exp2f(lg2 * (float)(127 - m));
        float o1[8], o2[8];
#pragma unroll
        for (int j = 0; j < 8; ++j) { o1[j] = (a[j] * cs[j] - bq[j] * sn[j]) * scl; o2[j] = (bq[j] * cs[j] + a[j] * sn[j]) * scl; }
        if (TRANSPOSED) {
#pragma unroll
            for (int j = 0; j < 8; ++j) { dst[(8 * i + j) * RP + m] = (bf16)f2bf(o1[j]); dst[(64 + 8 * i + j) * RP + m] = (bf16)f2bf(o2[j]); }
        } else {
            v4u w1, w2; w1.x = pk2(o1[0], o1[1]); w1.y = pk2(o1[2], o1[3]); w1.z = pk2(o1[4], o1[5]); w1.w = pk2(o1[6], o1[7]);
            w2.x = pk2(o2[0], o2[1]); w2.y = pk2(o2[2], o2[3]); w2.z = pk2(o2[4], o2[5]); w2.w = pk2(o2[6], o2[7]);
            *(LAS v4u*)(dst + m * RP + 8 * i) = w1; *(LAS v4u*)(dst + m * RP + 64 + 8 * i) = w2;
        }
    }
}
__device__ __forceinline__ void stage_vT(const bf16* h, size_t row0, int col0, LAS bf16* dst, int tid) {
#pragma unroll
    for (int k = 0; k < 4; ++k) {
        const int item = tid + 512 * k; const int m = item & 127, i = item >> 7;
        const v4u v = *(const v4u*)(h + (row0 + m) * INC + col0 + 8 * i);
        LAS bf16* d = dst + (8 * i) * RP + m;
        d[0 * RP] = (bf16)(v.x & 0xffffu); d[1 * RP] = (bf16)(v.x >> 16); d[2 * RP] = (bf16)(v.y & 0xffffu); d[3 * RP] = (bf16)(v.y >> 16);
        d[4 * RP] = (bf16)(v.z & 0xffffu); d[5 * RP] = (bf16)(v.z >> 16); d[6 * RP] = (bf16)(v.w & 0xffffu); d[7 * RP] = (bf16)(v.w >> 16);
    }
}
__device__ __forceinline__ float head_lg2(int hd) { return log2f(1.0f - exp2f(-5.0f - (float)hd)); }

__device__ __forceinline__ void ret_kv_phase(const Args& A, LAS unsigned char* lds, int vcu, int G, int tid, int wave, int lane) {
    const bf16* h = (const bf16*)(A.ws + WS_H); float* KV = (float*)(A.ws + WS_KV);
    const float* cosT = (const float*)(A.ws + WS_ROPE); const float* sinT = cosT + SEQ * 64;
    LAS bf16* KT = (LAS bf16*)lds; LAS bf16* VT = KT + 128 * RP;
    const int fr = lane & 15, fq = lane >> 4;
    for (int unit = vcu; unit < NB * RH * NCH; unit += G) {
        const int c = unit % NCH, hd = (unit / NCH) % RH, b = unit / (NCH * RH);
        const size_t row0 = (size_t)b * SEQ + c * RC;
        stage_rot<true, true>(h, row0, COL_K + hd * RD, c * RC, cosT, sinT, 1.0f, head_lg2(hd), KT, tid);
        stage_vT(h, row0, COL_V + hd * RD, VT, tid);
        __syncthreads();
        bf16x8 af[4];
#pragma unroll
        for (int km = 0; km < 4; ++km) af[km] = *(const LAS bf16x8*)(KT + (16 * wave + fr) * RP + 8 * fq + 32 * km);
        float* outp = KV + (size_t)unit * (RD * RD);
#pragma unroll
        for (int et = 0; et < 8; ++et) { f32x4 acc = {0.f, 0.f, 0.f, 0.f};
#pragma unroll
            for (int km = 0; km < 4; ++km) { const bf16x8 bfr = *(const LAS bf16x8*)(VT + (16 * et + fr) * RP + 8 * fq + 32 * km);
                acc = __builtin_amdgcn_mfma_f32_16x16x32_bf16(af[km], bfr, acc, 0, 0, 0); }
            *(f32x4*)(outp + (16 * et + fr) * RD + 16 * wave + 4 * fq) = acc; }
        __syncthreads();
    }
}
__device__ __forceinline__ void ret_scan_phase(const Args& A, int vcu, int G, int tid) {
    const float* KV = (const float*)(A.ws + WS_KV); bf16* SB = (bf16*)(A.ws + WS_SBF);
    const int gt = vcu * 512 + tid, NT = G * 512;
    for (int idx = gt; idx < NB * RH * (RD * RD / 4); idx += NT) {
        const int bh = idx >> 12, e4 = idx & 4095, hd = bh & 3;
        const float gC = exp2f(head_lg2(hd) * 128.0f);
        f32x4 st = {0.f, 0.f, 0.f, 0.f};
        const float* kp = KV + (size_t)bh * NCH * (RD * RD) + 4 * e4; bf16* sp = SB + (size_t)bh * NCH * (RD * RD) + 4 * e4;
#pragma unroll 8
        for (int c = 0; c < NCH; ++c) {
            v2u o; o.x = pk2(st.x, st.y); o.y = pk2(st.z, st.w); *(v2u*)(sp + (size_t)c * (RD * RD)) = o;
            const f32x4 kv = *(const f32x4*)(kp + (size_t)c * (RD * RD)); st = st * gC + kv; }
    }
}
__device__ __forceinline__ void ret_out_phase(const Args& A, LAS unsigned char* lds, int vcu, int G, int tid, int wave, int lane) {
    const bf16* h = (const bf16*)(A.ws + WS_H); const bf16* SB = (const bf16*)(A.ws + WS_SBF); bf16* cat = (bf16*)(A.ws + WS_CAT);
    const float* cosT = (const float*)(A.ws + WS_ROPE); const float* sinT = cosT + SEQ * 64;
    const float* gng = A.in[7]; const float* gnb = A.in[8];
    LAS bf16* Qs = (LAS bf16*)lds; LAS bf16* Ks = Qs + 128 * RP; LAS bf16* VT = Ks + 128 * RP; LAS bf16* ST = VT + 128 * RP;
    const int fr = lane & 15, fq = lane >> 4;
    for (int unit = vcu; unit < NB * RH * NCH; unit += G) {
        const int c = unit % NCH, hd = (unit / NCH) % RH, b = unit / (NCH * RH);
        const size_t row0 = (size_t)b * SEQ + c * RC; const float lg2 = head_lg2(hd);
        stage_rot<false, false>(h, row0, COL_Q + hd * RD, c * RC, cosT, sinT, 0.08838834764831845f, 0.f, Qs, tid);
        stage_rot<false, false>(h, row0, COL_K + hd * RD, c * RC, cosT, sinT, 1.0f, 0.f, Ks, tid);
        stage_vT(h, row0, COL_V + hd * RD, VT, tid);
        { const bf16* sp = SB + (size_t)unit * (RD * RD);
#pragma unroll
          for (int k = 0; k < 4; ++k) { const int item = tid + 512 * k; const int e = item >> 4, i = item & 15;
              *(LAS v4u*)(ST + e * RP + 8 * i) = *(const v4u*)(sp + e * RD + 8 * i); } }
        __syncthreads();
        bf16x8 qf[4];
#pragma unroll
        for (int kd = 0; kd < 4; ++kd) qf[kd] = *(const LAS bf16x8*)(Qs + (16 * wave + fr) * RP + 8 * fq + 32 * kd);
        v2u pk[8];
        const int n = 16 * wave + fr;
#pragma unroll
        for (int mt = 0; mt < 8; ++mt) {
            if (mt <= wave) {
                f32x4 s = {0.f, 0.f, 0.f, 0.f};
#pragma unroll
                for (int kd = 0; kd < 4; ++kd) { const bf16x8 kf = *(const LAS bf16x8*)(Ks + (16 * mt + fr) * RP + 8 * fq + 32 * kd);
                    s = __builtin_amdgcn_mfma_f32_16x16x32_bf16(kf, qf[kd], s, 0, 0, 0); }
                float p[4];
#pragma unroll
                for (int r = 0; r < 4; ++r) { const int m = 16 * mt + 4 * fq + r; const int rel = n - m; p[r] = (rel >= 0) ? s[r] * exp2f(lg2 * (float)rel) : 0.f; }
                pk[mt].x = pk2(p[0], p[1]); pk[mt].y = pk2(p[2], p[3]);
            } else { pk[mt].x = 0u; pk[mt].y = 0u; }
        }
        f32x4 yi[8], yc[8];
#pragma unroll
        for (int et = 0; et < 8; ++et) { yi[et] = (f32x4){0.f, 0.f, 0.f, 0.f}; yc[et] = (f32x4){0.f, 0.f, 0.f, 0.f}; }
#pragma unroll
        for (int kt = 0; kt < 4; ++kt) {
            if (2 * kt <= wave) {
                bf16x8 pf = __builtin_bit_cast(bf16x8, (v4u){pk[2 * kt].x, pk[2 * kt].y, pk[2 * kt + 1].x, pk[2 * kt + 1].y});
#pragma unroll
                for (int et = 0; et < 8; ++et) {
                    const LAS bf16* vp = VT + (16 * et + fr) * RP + 32 * kt + 4 * fq;
                    const v2u v0 = *(const LAS v2u*)vp, v1 = *(const LAS v2u*)(vp + 16);
                    const bf16x8 vf = __builtin_bit_cast(bf16x8, (v4u){v0.x, v0.y, v1.x, v1.y});
                    yi[et] = __builtin_amdgcn_mfma_f32_16x16x32_bf16(vf, pf, yi[et], 0, 0, 0); }
            }
        }
#pragma unroll
        for (int kd = 0; kd < 4; ++kd)
#pragma unroll
            for (int et = 0; et < 8; ++et) { const bf16x8 sf = *(const LAS bf16x8*)(ST + (16 * et + fr) * RP + 8 * fq + 32 * kd);
                yc[et] = __builtin_amdgcn_mfma_f32_16x16x32_bf16(sf, qf[kd], yc[et], 0, 0, 0); }
        const float qdec = exp2f(lg2 * (float)(n + 1));
        float s1 = 0.f;
#pragma unroll
        for (int et = 0; et < 8; ++et) { yi[et] = yi[et] + yc[et] * qdec; s1 += (yi[et].x + yi[et].y) + (yi[et].z + yi[et].w); }
        s1 += __shfl_xor(s1, 16); s1 += __shfl_xor(s1, 32);
        const float mean = s1 * (1.f / RD); float s2 = 0.f;
#pragma unroll
        for (int et = 0; et < 8; ++et) { yi[et] = yi[et] - mean; s2 += (yi[et].x * yi[et].x + yi[et].y * yi[et].y) + (yi[et].z * yi[et].z + yi[et].w * yi[et].w); }
        s2 += __shfl_xor(s2, 16); s2 += __shfl_xor(s2, 32);
        const float rstd = 1.f / sqrtf(s2 * (1.f / RD) + LN_EPS);
        const size_t row = row0 + n;
#pragma unroll
        for (int et = 0; et < 8; ++et) { const int e = 16 * et + 4 * fq;
            const f32x4 gg = *(const f32x4*)(gng + hd * RD + e), gb = *(const f32x4*)(gnb + hd * RD + e);
            const v2u gw = *(const v2u*)(h + row * INC + COL_G + hd * RD + e);
            const float g0 = bflo(gw.x), g1 = bfhi(gw.x), g2 = bflo(gw.y), g3 = bfhi(gw.y);
            f32x4 o = yi[et] * rstd * gg + gb;
            o.x *= g0 * sigmoidf_(g0); o.y *= g1 * sigmoidf_(g1); o.z *= g2 * sigmoidf_(g2); o.w *= g3 * sigmoidf_(g3);
            v2u w; w.x = pk2(o.x, o.y); w.y = pk2(o.z, o.w);
            *(v2u*)(cat + row * DM + CW + hd * RD + e) = w; }
        __syncthreads();
    }
}

constexpr int XP = 264;
__device__ __forceinline__ void xattn_phase(const Args& A, LAS unsigned char* lds, int vcu, int G, int tid, int wave, int lane) {
    bf16* QO = (bf16*)(A.ws + WS_CAT); const bf16* KM = (const bf16*)(A.ws + WS_KM); const bf16* VTm = (const bf16*)(A.ws + WS_VT);
    LAS bf16* L = (LAS bf16*)lds;
    const int fr = lane & 15, fq = lane >> 4;
    constexpr float SC = 0.0625f * 1.4426950408889634f;
    for (int unit = vcu; unit < NB * XH * (SEQ / 128); unit += G) {
        const int qb = unit % (SEQ / 128), hd = (unit / (SEQ / 128)) % XH, b = unit / ((SEQ / 128) * XH);
#pragma unroll
        for (int k = 0; k < 16; ++k) { const int item = tid + 512 * k; const int m = item >> 5, i = item & 31;
            *(LAS v4u*)(L + m * XP + 8 * i) = *(const v4u*)(KM + ((size_t)b * NMEM + m) * DM + hd * XD + 8 * i); }
        const size_t row = (size_t)b * SEQ + qb * 128 + 16 * wave + fr;
        bf16x8 qf[8];
#pragma unroll
        for (int kd = 0; kd < 8; ++kd) qf[kd] = *(const bf16x8*)(QO + row * DM + hd * XD + 8 * fq + 32 * kd);
        __syncthreads();
        f32x4 s[16];
#pragma unroll
        for (int mt = 0; mt < 16; ++mt) { s[mt] = (f32x4){0.f, 0.f, 0.f, 0.f};
#pragma unroll
            for (int kd = 0; kd < 8; ++kd) { const bf16x8 kf = *(const LAS bf16x8*)(L + (16 * mt + fr) * XP + 8 * fq + 32 * kd);
                s[mt] = __builtin_amdgcn_mfma_f32_16x16x32_bf16(kf, qf[kd], s[mt], 0, 0, 0); } }
        float mx = -3.0e38f;
#pragma unroll
        for (int mt = 0; mt < 16; ++mt) mx = fmaxf(mx, fmaxf(fmaxf(s[mt].x, s[mt].y), fmaxf(s[mt].z, s[mt].w)));
        mx = fmaxf(mx, __shfl_xor(mx, 16)); mx = fmaxf(mx, __shfl_xor(mx, 32));
        float sum = 0.f; v2u pk[16];
#pragma unroll
        for (int mt = 0; mt < 16; ++mt) { f32x4 p;
#pragma unroll
            for (int r = 0; r < 4; ++r) p[r] = exp2f((s[mt][r] - mx) * SC);
            sum += (p.x + p.y) + (p.z + p.w); pk[mt].x = pk2(p.x, p.y); pk[mt].y = pk2(p.z, p.w); }
        sum += __shfl_xor(sum, 16); sum += __shfl_xor(sum, 32);
        const float inv = 1.0f / sum;
        __syncthreads();
#pragma unroll
        for (int k = 0; k < 16; ++k) { const int item = tid + 512 * k; const int d = item >> 5, i = item & 31;
            *(LAS v4u*)(L + d * XP + 8 * i) = *(const v4u*)(VTm + ((size_t)hd * XD + d) * MEMT + b * NMEM + 8 * i); }
        __syncthreads();
        f32x4 o[16];
#pragma unroll
        for (int dt = 0; dt < 16; ++dt) o[dt] = (f32x4){0.f, 0.f, 0.f, 0.f};
#pragma unroll
        for (int kt = 0; kt < 8; ++kt) {
            const bf16x8 pf = __builtin_bit_cast(bf16x8, (v4u){pk[2 * kt].x, pk[2 * kt].y, pk[2 * kt + 1].x, pk[2 * kt + 1].y});
#pragma unroll
            for (int dt = 0; dt < 16; ++dt) { const LAS bf16* vp = L + (16 * dt + fr) * XP + 32 * kt + 4 * fq;
                const v2u v0 = *(const LAS v2u*)vp, v1 = *(const LAS v2u*)(vp + 16);
                const bf16x8 vf = __builtin_bit_cast(bf16x8, (v4u){v0.x, v0.y, v1.x, v1.y});
                o[dt] = __builtin_amdgcn_mfma_f32_16x16x32_bf16(vf, pf, o[dt], 0, 0, 0); } }
#pragma unroll
        for (int dt = 0; dt < 16; ++dt) { const f32x4 v = o[dt] * inv; v2u w; w.x = pk2(v.x, v.y); w.y = pk2(v.z, v.w);
            *(v2u*)(QO + row * DM + hd * XD + 16 * dt + 4 * fq) = w; }
        __syncthreads();
    }
}

__global__ void __launch_bounds__(NWAVES * 64, 2) fwd_megakernel(Args args) {
    extern __shared__ __attribute__((aligned(16))) unsigned char lds_raw[];
    LAS unsigned char* lds = (LAS unsigned char*)lds_raw;
    const int tid = threadIdx.x, lane = tid & 63, wave = __builtin_amdgcn_readfirstlane(tid >> 6);
    const int G = gridDim.x; const int bx = blockIdx.x; const int vcu = (G % 8 == 0) ? (bx % 8) * (G / 8) + bx / 8 : bx;
    unsigned char* ws = args.ws;
    const int lo = args.ph_lo, hi = args.ph_hi;
    cg::grid_group grid = cg::this_grid();
#define IN(k) (lo <= (k) && (k) < hi)
#define SEAM(k) do { if (IN(k) && IN((k) + 1)) grid.sync(); } while (0)
    bf16* XB = (bf16*)(ws + WS_XB); bf16* CAT = (bf16*)(ws + WS_CAT); bf16* H = (bf16*)(ws + WS_H); bf16* HID = (bf16*)(ws + WS_HID);

    if (IN(0)) { p0_prologue(args, lds, vcu, G, tid, wave, lane); __syncthreads(); }
    SEAM(0);
    if (IN(1)) {
        { pg8::Gemm g{(const bf16*)(ws + WS_MEMB), (const bf16*)(ws + WS_WXK), MEMT, DM, DM}; pg8::StaticOrder S; S.init(MEMT, DM, G, bx);
          pg8::EpiStoreBf16<0> E{(bf16*)(ws + WS_KM), DM};
          pg8::gemm_phase<pg8::EpiStoreBf16<0>, pg8::StaticOrder, true, true>(lds, g, S, E); }
        { pg8::Gemm g{(const bf16*)(ws + WS_WXV), (const bf16*)(ws + WS_MEMB), DM, MEMT, DM}; pg8::StaticOrder S; S.init(DM, MEMT, G, (bx + G - 32) % G);
          pg8::EpiStoreBf16<0> E{(bf16*)(ws + WS_VT), MEMT};
          pg8::gemm_phase<pg8::EpiStoreBf16<0>, pg8::StaticOrder, true, true>(lds, g, S, E); }
        { pg8::Gemm g{XB, (const bf16*)(ws + WS_WIN), T, INC, DM}; pg8::StaticOrder S; S.init(T, INC, G, bx);
          pg8::EpiStoreBf16<0> E{H, INC};
          pg8::gemm_phase<pg8::EpiStoreBf16<0>, pg8::StaticOrder, true, true>(lds, g, S, E); }
    }
    SEAM(1);
    if (IN(2)) { conv_phase(args, lds, vcu, G, tid, wave, lane); ret_kv_phase(args, lds, vcu, G, tid, wave, lane); }
    SEAM(2);
    if (IN(3)) ret_scan_phase(args, vcu, G, tid);
    SEAM(3);
    if (IN(4)) ret_out_phase(args, lds, vcu, G, tid, wave, lane);
    SEAM(4);
    if (IN(5)) {
        pg8::Gemm g{CAT, (const bf16*)(ws + WS_WOUT), T, DM, DM}; pg8::StaticOrder S; S.init(T, DM, G, bx);
        pg8::EpiResF32 E{args.in[0], args.out, DM, DN_ALPHA};
        pg8::gemm_phase<pg8::EpiResF32, pg8::StaticOrder, true, true>(lds, g, S, E);
    }
    SEAM(5);
    if (IN(6)) ln_phase(args.out, args.in[10], args.in[11], XB, vcu, G, wave, lane);
    SEAM(6);
    if (IN(7)) {
        pg8::Gemm g{XB, (const bf16*)(ws + WS_WXQ), T, DM, DM}; pg8::StaticOrder S; S.init(T, DM, G, bx);
        pg8::EpiStoreBf16<0> E{CAT, DM};
        pg8::gemm_phase<pg8::EpiStoreBf16<0>, pg8::StaticOrder, true, true>(lds, g, S, E);
    }
    SEAM(7);
    if (IN(8)) xattn_phase(args, lds, vcu, G, tid, wave, lane);
    SEAM(8);
    if (IN(9)) {
        pg8::Gemm g{CAT, (const bf16*)(ws + WS_WXO), T, DM, DM}; pg8::StaticOrder S; S.init(T, DM, G, bx);
        pg8::EpiResF32 E{args.out, args.out, DM, DN_ALPHA};
        pg8::gemm_phase<pg8::EpiResF32, pg8::StaticOrder, true, true>(lds, g, S, E);
    }
    SEAM(9);
    if (IN(10)) ln_phase(args.out, args.in[16], args.in[17], XB, vcu, G, wave, lane);
    SEAM(10);
    if (IN(11)) {
        pg8::Gemm g{XB, (const bf16*)(ws + WS_WUP), T, FF, DM}; pg8::StaticOrder S; S.init(T, FF, G, bx);
        pg8::EpiStoreBf16<1> E{HID, FF};
        pg8::gemm_phase<pg8::EpiStoreBf16<1>, pg8::StaticOrder, true, true>(lds, g, S, E);
    }
    SEAM(11);
    if (IN(12)) {
        pg8::Gemm g{HID, (const bf16*)(ws + WS_WDN), T, DM, FF}; pg8::StaticOrder S; S.init(T, DM, G, bx);
        pg8::EpiResF32 E{args.out, args.out, DM, DN_ALPHA};
        pg8::gemm_phase<pg8::EpiResF32, pg8::StaticOrder, true, true>(lds, g, S, E);
    }
    SEAM(12);
    if (IN(13)) ln_phase(args.out, args.in[20], args.in[21], nullptr, vcu, G, wave, lane);
#undef IN
#undef SEAM
}

#ifndef MK_MULTI
#define MK_MULTI 0
#endif
extern "C" void kernel_launch(void* const* d_in, const int* in_sizes, int n_in, void* d_out, int out_size, void* d_ws, size_t ws_size, hipStream_t stream) {
    static int grid = 0;
    if (grid == 0) {
        if (n_in != 22 || out_size != T * DM || ws_size < WS_END) { fprintf(stderr, "kernel_launch: unexpected problem (n_in %d, out %d, ws %zu)\n", n_in, out_size, ws_size); grid = -1; return; }
        int dev = 0, cus = 0, per_cu = 0;
        if (hipGetDevice(&dev) != hipSuccess || hipDeviceGetAttribute(&cus, hipDeviceAttributeMultiprocessorCount, dev) != hipSuccess) { grid = -1; return; }
        if (hipFuncSetAttribute((const void*)fwd_megakernel, hipFuncAttributeMaxDynamicSharedMemorySize, LDS_BYTES) != hipSuccess) { fprintf(stderr, "kernel_launch: hipFuncSetAttribute failed\n"); grid = -1; return; }
        if (hipOccupancyMaxActiveBlocksPerMultiprocessor(&per_cu, (const void*)fwd_megakernel, NWAVES * 64, LDS_BYTES) != hipSuccess || per_cu < 1) { fprintf(stderr, "kernel_launch: occupancy query gave %d\n", per_cu); (void)hipGetLastError(); per_cu = 1; }
        grid = cus * (per_cu > 1 ? 1 : per_cu);
    }
    if (grid < 0) return;
    Args a{};
    for (int i = 0; i < 22; ++i) a.in[i] = (const float*)d_in[i];
    a.out = (float*)d_out; a.ws = (unsigned char*)d_ws;
#if MK_MULTI
    for (int p = 0; p < NPHASE; ++p) {
        a.ph_lo = p; a.ph_hi = p + 1;
        void* kargs[] = {&a};
        hipError_t e = hipLaunchCooperativeKernel((const void*)fwd_megakernel, dim3(grid), dim3(NWAVES * 64), kargs, LDS_BYTES, stream);
        if (e != hipSuccess) { fprintf(stderr, "kernel_launch: launch of phase %d failed: %s\n", p, hipGetErrorString(e)); break; }
    }
#else
    a.ph_lo = 0; a.ph_hi = NPHASE;
    void* kargs[] = {&a};
    hipError_t e = hipLaunchCooperativeKernel((const void*)fwd_megakernel, dim3(grid), dim3(NWAVES * 64), kargs, LDS_BYTES, stream);
    if (e != hipSuccess) fprintf(stderr, "kernel_launch: cooperative launch failed: %s (grid %d)\n", hipGetErrorString(e), grid);
#endif
}
```

```cpp
#include <hip/hip_runtime.h>
#include <hip/hip_cooperative_groups.h>
#include <cstdio>
#include <cstdint>
namespace cg = cooperative_groups;
namespace pg8 {
#define PG8_LAS __attribute__((address_space(3)))
typedef unsigned short bf16_t;
typedef short bf16x8 __attribute__((ext_vector_type(8)));
typedef float f32x4 __attribute__((ext_vector_type(4)));
typedef unsigned u32x4 __attribute__((ext_vector_type(4)));
constexpr int BM = 256, BK = 64, HALF = 128, HTB = HALF * BK * 2  , STAGE_BYTES = 8 * HTB, NXCD = 8, WGM = 8;

__host__ __device__ __forceinline__ int lds_byte(int r, int c) { const int st = (r >> 4) * 2 + (c >> 5), rr = r & 15, cc = c & 31, ob = rr * 64 + cc * 2; return st * 1024 + (ob ^ (((ob >> 9) & 1) << 5)); }
__host__ __device__ __forceinline__ void stage_rc(int b, int& R, int& C) { const int st = b / 1024, sb = b % 1024, swz = sb ^ (((sb >> 9) & 1) << 5); R = (st >> 1) * 16 + swz / 64; C = (st & 1) * 32 + (swz % 64) / 2; }
__host__ __device__ __forceinline__ int perm32(int rho) { const int n = rho >> 4, i = rho & 15; return 8 * (i >> 2) + 4 * n + (i & 3); }

struct Unit { int pm, pn; };
struct Gemm { const bf16_t* A; const bf16_t* Bt; int M, N, K; };

struct StaticOrder {
    int nM, nN, nwg, G, c;
    __host__ __device__ void init(int M, int N, int G_, int c_) { nM = M / BM; nN = N / BM; nwg = nM * nN; G = G_; c = c_; }
    __host__ __device__ bool next(int i, Unit& u) const {
        const long L = (long)i * G + c; if (L >= nwg) return false;
        int wgid = (int)L; { const int q = nwg / NXCD, r = nwg % NXCD, xcd = wgid % NXCD, off = wgid / NXCD; wgid = (xcd < r ? xcd * (q + 1) : r * (q + 1) + (xcd - r) * q) + off; }
        const int nig = WGM * nN, gid = wgid / nig, fm = gid * WGM, gsz = (nM - fm) < WGM ? (nM - fm) : WGM;
        u.pm = fm + ((wgid % nig) % gsz); u.pn = (wgid % nig) / gsz; return true;
    }
    __device__ __forceinline__ void a_ready(const Unit&) const {}
    __device__ __forceinline__ void done(const Unit&) const {}
};

__device__ __forceinline__ unsigned cvt_pk_bf16(float lo, float hi) { unsigned r; asm volatile("v_cvt_pk_bf16_f32 %0, %1, %2" : "=v"(r) : "v"(lo), "v"(hi)); return r; }
typedef float f32x2 __attribute__((ext_vector_type(2)));
__device__ __forceinline__ f32x2 gelu_pk(f32x2 v) {
    const f32x2 av = __builtin_elementwise_abs(v), d = av * 0.2316418882f + 1.0f;
    f32x2 t; t.x = __builtin_amdgcn_rcpf(d.x); t.y = __builtin_amdgcn_rcpf(d.y);
    f32x2 q = t * 0.5307027145f + (-0.7265760135f); q = q * t + 0.7107068705f; q = q * t + (-0.142248368f); q = q * t + 0.127414796f; q = q * t;
    const f32x2 s = (v * v) * (-0.72134752044f);
    f32x2 e; e.x = __builtin_amdgcn_exp2f(s.x); e.y = __builtin_amdgcn_exp2f(s.y);
    const f32x2 m = v * (q * e), r = v - m;
    f32x2 o; o.x = v.x < 0.f ? m.x : r.x; o.y = v.y < 0.f ? m.y : r.y; return o;
}

template <int ACT  > struct EpiBf16 {
    static constexpr bool PERM = true, AFTER_DRAIN = false; static_assert(ACT == 0 || ACT == 1, "EpiBf16: ACT is 0 (none) or 1 (gelu_pk)");
    bf16_t* O; int ldc; const float* bias; int split_cols; size_t split_stride; float scale0;
    __device__ __forceinline__ void operator()(const f32x4 (&acc)[2][2][4][2], const Unit& u, int wr, int wc, int fr, int fq) const {
        const int row0 = u.pm * BM + wr * 64 + fr; int colt = u.pn * BM; bf16_t* base = O;
        float sc = 1.f; if (split_cols) { const int t = colt / split_cols; base += (size_t)t * split_stride; colt -= t * split_cols; if (t == 0) sc = scale0; }
        const int col0 = colt + wc * 32 + 8 * fq, bcol0 = u.pn * BM + wc * 32 + 8 * fq;
        f32x4 bv[2][2];
#pragma unroll
        for (int bj = 0; bj < 2; ++bj)
#pragma unroll
            for (int n = 0; n < 2; ++n) bv[bj][n] = bias ? *(const f32x4*)(bias + bcol0 + bj * HALF + 4 * n) : (f32x4){0.f, 0.f, 0.f, 0.f};
#pragma unroll
        for (int ai = 0; ai < 2; ++ai)
#pragma unroll
            for (int m = 0; m < 4; ++m) { bf16_t* rowp = base + (size_t)(row0 + ai * HALF + m * 16) * ldc + col0;
#pragma unroll
                for (int bj = 0; bj < 2; ++bj) { f32x4 v0 = acc[ai][bj][m][0] + bv[bj][0], v1 = acc[ai][bj][m][1] + bv[bj][1];
                    if (ACT == 1) { f32x2 a = gelu_pk((f32x2){v0[0], v0[1]}), b = gelu_pk((f32x2){v0[2], v0[3]}), c = gelu_pk((f32x2){v1[0], v1[1]}), d = gelu_pk((f32x2){v1[2], v1[3]});
                        v0 = (f32x4){a.x, a.y, b.x, b.y}; v1 = (f32x4){c.x, c.y, d.x, d.y}; }
                    v0 = v0 * sc; v1 = v1 * sc; u32x4 w; w.x = cvt_pk_bf16(v0[0], v0[1]); w.y = cvt_pk_bf16(v0[2], v0[3]); w.z = cvt_pk_bf16(v1[0], v1[1]); w.w = cvt_pk_bf16(v1[2], v1[3]);
                    *(u32x4*)(rowp + bj * HALF) = w; } }
    }
};
template <int ACT  > struct EpiStoreBf16 {
    static constexpr bool PERM = true, AFTER_DRAIN = false;
    bf16_t* O; int ldc;
    __device__ __forceinline__ void operator()(const f32x4 (&acc)[2][2][4][2], const Unit& u, int wr, int wc, int fr, int fq) const {
        const int row0 = u.pm * BM + wr * 64 + fr; const int col0 = u.pn * BM + wc * 32 + 8 * fq;
#pragma unroll
        for (int ai = 0; ai < 2; ++ai)
#pragma unroll
            for (int m = 0; m < 4; ++m) { bf16_t* rowp = O + (size_t)(row0 + ai * HALF + m * 16) * ldc + col0;
#pragma unroll
                for (int bj = 0; bj < 2; ++bj) { f32x4 v0 = acc[ai][bj][m][0], v1 = acc[ai][bj][m][1];
                    if (ACT == 1) {
#pragma unroll
                        for (int e = 0; e < 4; ++e) { const float a = fmaxf(v0[e], 0.f), b = fmaxf(v1[e], 0.f); v0[e] = a * a; v1[e] = b * b; } }
                    u32x4 w; w.x = cvt_pk_bf16(v0[0], v0[1]); w.y = cvt_pk_bf16(v0[2], v0[3]); w.z = cvt_pk_bf16(v1[0], v1[1]); w.w = cvt_pk_bf16(v1[2], v1[3]);
                    *(u32x4*)(rowp + bj * HALF) = w; } }
    }
};
struct EpiResF32 {
    static constexpr bool PERM = false, AFTER_DRAIN = false;
    const float* base; float* out; int ldc; float alpha;
    __device__ __forceinline__ void operator()(const f32x4 (&acc)[2][2][4][2], const Unit& u, int wr, int wc, int fr, int fq) const {
        const int col0 = u.pn * BM + wc * 32 + 4 * fq;
#pragma unroll
        for (int ai = 0; ai < 2; ++ai)
#pragma unroll
            for (int m = 0; m < 4; ++m) { const size_t off = (size_t)(u.pm * BM + ai * HALF + wr * 64 + m * 16 + fr) * ldc + col0;
#pragma unroll
                for (int bj = 0; bj < 2; ++bj)
#pragma unroll
                    for (int n = 0; n < 2; ++n) { const f32x4 bs = *(const f32x4*)(base + off + bj * HALF + n * 16); const f32x4 o = bs * alpha + acc[ai][bj][m][n];
                        *(f32x4*)(out + off + bj * HALF + n * 16) = o; } }
    }
};
template <class Epi, class Sched, bool ALIGN_EPI = false, bool SP2 = false>
__device__ __forceinline__ void gemm_phase(PG8_LAS unsigned char* lds, const Gemm g, const Sched& S, const Epi& E) {
    const int tid = threadIdx.x, wid = __builtin_amdgcn_readfirstlane(tid >> 6), lane = tid & 63, wr = wid >> 2, wc = wid & 3, fr = lane & 15, fq = lane >> 4;
    const int K = g.K, nt = K / BK;
    unsigned voffA[2], voffB[2];
#pragma unroll
    for (int i = 0; i < 2; ++i) { int R, C; stage_rc(tid * 16 + i * 8192, R, C); const int Rb = Epi::PERM ? ((R & ~31) + perm32(R & 31)) : R;
        voffA[i] = (unsigned)(R * K + C) * 2u; voffB[i] = (unsigned)(Rb * K + C) * 2u; }
    const size_t kstep = (size_t)(BK * 2);
    const size_t hstep = (size_t)HALF * K * 2;
    const size_t tstep = 2 * hstep;
    const unsigned ldsw = (unsigned)wid * 1024u;
    const int aoff = lds_byte(wr * 64 + fr, fq * 8), boff = lds_byte(wc * 32 + fr, fq * 8);
#define PG8_SA(b, h) (((b) * 2 + (h)) * HTB)
#define PG8_SB(b, h) ((4 + (b) * 2 + (h)) * HTB)
#define PG8_STAGE(bufoff, gbase, voff) do { _Pragma("unroll") for (int _i = 0; _i < 2; ++_i) \
        __builtin_amdgcn_global_load_lds((const unsigned*)((const char*)(gbase) + (voff)[_i]), (PG8_LAS unsigned*)(lds + (bufoff) + ldsw + _i * 8192), 16, 0, 0); } while (0)
#define PG8_LDA(dst, b, h) do { _Pragma("unroll") for (int m = 0; m < 4; ++m) _Pragma("unroll") for (int k = 0; k < 2; ++k) dst[m][k] = *(const PG8_LAS bf16x8*)(lds + PG8_SA(b, h) + aoff + m * 2048 + k * 1024); } while (0)
#define PG8_LDB(dst, b, h) do { _Pragma("unroll") for (int n = 0; n < 2; ++n) _Pragma("unroll") for (int k = 0; k < 2; ++k) dst[n][k] = *(const PG8_LAS bf16x8*)(lds + PG8_SB(b, h) + boff + n * 2048 + k * 1024); } while (0)
#define PG8_MMA(ai, bj, At, Bt) do { __builtin_amdgcn_s_setprio(1); _Pragma("unroll") for (int m = 0; m < 4; ++m) _Pragma("unroll") for (int n = 0; n < 2; ++n) _Pragma("unroll") for (int k = 0; k < 2; ++k) \
        acc[ai][bj][m][n] = __builtin_amdgcn_mfma_f32_16x16x32_bf16(Bt[n][k], At[m][k], acc[ai][bj][m][n], 0, 0, 0); __builtin_amdgcn_s_setprio(0); } while (0)
#define PG8_WAIT_V(n) asm volatile("s_waitcnt vmcnt(" #n ")" ::: "memory")
#define PG8_WAIT_L(n) asm volatile("s_waitcnt lgkmcnt(" #n ")" ::: "memory")
#define PG8_BAR __builtin_amdgcn_s_barrier()
#define PG8_SCHED __builtin_amdgcn_sched_barrier(0)
    Unit cur, nxt; int ui = 0;
    if (!S.next(0, cur)) return;
    f32x4 acc[2][2][4][2];
#pragma unroll
    for (int a = 0; a < 2; ++a)
#pragma unroll
        for (int b = 0; b < 2; ++b)
#pragma unroll
            for (int m = 0; m < 4; ++m)
#pragma unroll
                for (int n = 0; n < 2; ++n) acc[a][b][m][n] = (f32x4){0.f, 0.f, 0.f, 0.f};
    bf16x8 At[4][2], B0[2][2], B1[2][2];
    const char* cA = (const char*)g.A + (size_t)cur.pm * tstep; const char* cB = (const char*)g.Bt + (size_t)cur.pn * tstep;
    S.a_ready(cur);
    if constexpr (SP2) {
        PG8_STAGE(PG8_SB(0, 0), cB, voffB); PG8_STAGE(PG8_SB(0, 1), cB + hstep, voffB); PG8_STAGE(PG8_SA(0, 0), cA, voffA); PG8_STAGE(PG8_SA(0, 1), cA + hstep, voffA);
        if (wr == 1) PG8_BAR;
        PG8_WAIT_V(2); PG8_BAR;
        PG8_STAGE(PG8_SB(1, 0), cB + kstep, voffB); PG8_STAGE(PG8_SA(1, 0), cA + kstep, voffA); PG8_STAGE(PG8_SB(1, 1), cB + hstep + kstep, voffB);
        PG8_WAIT_V(6); PG8_BAR;
    } else {
        PG8_STAGE(PG8_SB(0, 0), cB, voffB); PG8_STAGE(PG8_SA(0, 0), cA, voffA); PG8_STAGE(PG8_SB(0, 1), cB + hstep, voffB); PG8_STAGE(PG8_SA(0, 1), cA + hstep, voffA);
        if (wr == 1) PG8_BAR;
        PG8_WAIT_V(4); PG8_BAR;
        PG8_STAGE(PG8_SB(1, 0), cB + kstep, voffB); PG8_STAGE(PG8_SA(1, 0), cA + kstep, voffA); PG8_STAGE(PG8_SB(1, 1), cB + hstep + kstep, voffB);
        PG8_WAIT_V(6); PG8_BAR;
    }
    for (;;) {
        const bool has_next = S.next(ui + 1, nxt);
        const char* nA = has_next ? (const char*)g.A + (size_t)nxt.pm * tstep : cA; const char* nB = has_next ? (const char*)g.Bt + (size_t)nxt.pn * tstep : cB;
        for (int t = 0; t < nt; t += 2) {
            const bool last = (t == nt - 2);
            const char* a1 = cA + (size_t)(t + 1) * kstep;
            const char* a2 = last ? nA : cA + (size_t)(t + 2) * kstep; const char* b2 = last ? nB : cB + (size_t)(t + 2) * kstep;
            const char* a3 = a2 + kstep; const char* b3 = b2 + kstep;
            if (last && has_next) S.a_ready(nxt);
            if constexpr (SP2) {
            PG8_LDB(B0, 0, 0); PG8_LDB(B1, 0, 1); PG8_SCHED; PG8_LDA(At, 0, 0); PG8_STAGE(PG8_SA(1, 1), a1 + hstep, voffA);
            PG8_WAIT_V(8); PG8_WAIT_L(0); PG8_BAR; PG8_MMA(0, 0, At, B0); PG8_MMA(0, 1, At, B1); PG8_BAR; PG8_SCHED;
            PG8_LDA(At, 0, 1); PG8_STAGE(PG8_SB(0, 0), b2, voffB); PG8_STAGE(PG8_SB(0, 1), b2 + hstep, voffB); PG8_STAGE(PG8_SA(0, 0), a2, voffA);
            PG8_WAIT_V(8); PG8_WAIT_L(0); PG8_BAR; PG8_MMA(1, 0, At, B0); PG8_MMA(1, 1, At, B1); PG8_BAR; PG8_SCHED;
            PG8_LDB(B0, 1, 0); PG8_LDB(B1, 1, 1); PG8_SCHED; PG8_LDA(At, 1, 0); PG8_STAGE(PG8_SA(0, 1), a2 + hstep, voffA);
            PG8_WAIT_V(8); PG8_WAIT_L(0); PG8_BAR; PG8_MMA(0, 0, At, B0); PG8_MMA(0, 1, At, B1); PG8_BAR; PG8_SCHED;
            PG8_LDA(At, 1, 1); PG8_STAGE(PG8_SB(1, 0), b3, voffB); PG8_STAGE(PG8_SB(1, 1), b3 + hstep, voffB); PG8_STAGE(PG8_SA(1, 0), a3, voffA);
            PG8_WAIT_V(8); PG8_WAIT_L(0); PG8_BAR; PG8_MMA(1, 0, At, B0); PG8_MMA(1, 1, At, B1); PG8_BAR; PG8_SCHED;
            } else {
            PG8_LDB(B0, 0, 0); PG8_SCHED; PG8_LDA(At, 0, 0); PG8_STAGE(PG8_SA(1, 1), a1 + hstep, voffA);
            PG8_WAIT_L(8); PG8_BAR; PG8_WAIT_L(0); PG8_MMA(0, 0, At, B0); PG8_BAR; PG8_SCHED;
            PG8_LDB(B1, 0, 1); PG8_STAGE(PG8_SB(0, 0), b2, voffB);
            PG8_BAR; PG8_WAIT_L(0); PG8_MMA(0, 1, At, B1); PG8_BAR;
            PG8_LDA(At, 0, 1); PG8_STAGE(PG8_SA(0, 0), a2, voffA);
            PG8_BAR; PG8_WAIT_L(0); PG8_MMA(1, 0, At, B0); PG8_BAR; PG8_SCHED;
            PG8_STAGE(PG8_SB(0, 1), b2 + hstep, voffB);
            PG8_WAIT_V(6); PG8_BAR; PG8_MMA(1, 1, At, B1); PG8_BAR;
            PG8_LDB(B0, 1, 0); PG8_SCHED; PG8_LDA(At, 1, 0); PG8_STAGE(PG8_SA(0, 1), a2 + hstep, voffA);
            PG8_WAIT_L(8); PG8_BAR; PG8_WAIT_L(0); PG8_MMA(0, 0, At, B0); PG8_BAR; PG8_SCHED;
            PG8_LDB(B1, 1, 1); PG8_STAGE(PG8_SB(1, 0), b3, voffB);
            PG8_BAR; PG8_WAIT_L(0); PG8_MMA(0, 1, At, B1); PG8_BAR;
            PG8_LDA(At, 1, 1); PG8_STAGE(PG8_SA(1, 0), a3, voffA);
            PG8_BAR; PG8_WAIT_L(0); PG8_MMA(1, 0, At, B0); PG8_BAR; PG8_SCHED;
            PG8_STAGE(PG8_SB(1, 1), b3 + hstep, voffB);
            PG8_WAIT_V(6); PG8_BAR; PG8_MMA(1, 1, At, B1); PG8_BAR;
            }
        }
        if constexpr (ALIGN_EPI) { if (wr == 0) PG8_BAR; }
        if constexpr (!Epi::AFTER_DRAIN) { E(acc, cur, wr, wc, fr, fq); S.done(cur); }
        if (!has_next) break;
#pragma unroll
        for (int a = 0; a < 2; ++a)
#pragma unroll
            for (int b = 0; b < 2; ++b)
#pragma unroll
                for (int m = 0; m < 4; ++m)
#pragma unroll
                    for (int n = 0; n < 2; ++n) acc[a][b][m][n] = (f32x4){0.f, 0.f, 0.f, 0.f};
        cur = nxt; cA = nA; cB = nB; ++ui;
        if constexpr (ALIGN_EPI) { if (wr == 1) PG8_BAR; }
    }
    PG8_WAIT_V(0);
    if constexpr (!ALIGN_EPI) { if (wr == 0) PG8_BAR; }
    PG8_BAR;
    if constexpr (Epi::AFTER_DRAIN) { E.fused(acc, cur, wr, wc, fr, fq, lds, wid, lane); S.done(cur); }
#undef PG8_SA
#undef PG8_SB
#undef PG8_STAGE
#undef PG8_LDA
#undef PG8_LDB
#undef PG8_MMA
#undef PG8_WAIT_V
#undef PG8_WAIT_L
#undef PG8_BAR
#undef PG8_SCHED
}
}

constexpr int NB = 8, SEQ = 4096, DM = 1024, T = NB * SEQ, NMEM = 256, MEMT = NB * NMEM;
constexpr int CW = 512, CKW = 31, RH = 4, RD = 128, RC = 128, NCH = SEQ / RC, INC = 3072;
constexpr int COL_A = 0, COL_B = 512, COL_Q = 1024, COL_K = 1536, COL_V = 2048, COL_G = 2560;
constexpr int XH = 4, XD = 256, FF = 4096;
constexpr float LN_EPS = 1e-5f;
constexpr float DN_ALPHA = 1.189207115002721f;
constexpr int NPHASE = 14;

constexpr size_t MiB = 1u << 20;
constexpr size_t WS_ROPE = 2 * MiB;
constexpr size_t WS_WIN = 8 * MiB, WS_WOUT = 14 * MiB, WS_WXQ = 16 * MiB, WS_WXK = 18 * MiB, WS_WXV = 20 * MiB, WS_WXO = 22 * MiB, WS_WUP = 24 * MiB, WS_WDN = 32 * MiB;
constexpr size_t WS_MEMB = 40 * MiB, WS_KM = 44 * MiB, WS_VT = 48 * MiB;
constexpr size_t WS_XB = 64 * MiB;
constexpr size_t WS_CAT = 128 * MiB;
constexpr size_t WS_H = 192 * MiB;
constexpr size_t WS_KV = 384 * MiB;
constexpr size_t WS_SBF = 448 * MiB;
constexpr size_t WS_HID = 192 * MiB;
constexpr size_t WS_END = 480 * MiB;

constexpr int LDS_BYTES = 147456;
constexpr int NWAVES = 8;

#define GAS __attribute__((address_space(1)))
#define LAS __attribute__((address_space(3)))
typedef unsigned short bf16;
typedef unsigned v4u __attribute__((ext_vector_type(4)));
typedef unsigned v2u __attribute__((ext_vector_type(2)));
typedef float f32x4 __attribute__((ext_vector_type(4)));
typedef short bf16x8 __attribute__((ext_vector_type(8)));
typedef short s16x4 __attribute__((ext_vector_type(4)));
#define LDS_WAIT() asm volatile("s_waitcnt lgkmcnt(0)" ::: "memory")

__device__ __forceinline__ unsigned f2bf(float f) { unsigned u = __builtin_bit_cast(unsigned, f); return (u + 0x7fffu + ((u >> 16) & 1u)) >> 16; }
__device__ __forceinline__ unsigned pk2(float lo, float hi) { return f2bf(lo) | (f2bf(hi) << 16); }
__device__ __forceinline__ float bflo(unsigned w) { return __builtin_bit_cast(float, w << 16); }
__device__ __forceinline__ float bfhi(unsigned w) { return __builtin_bit_cast(float, w & 0xffff0000u); }
__device__ __forceinline__ float bf1(bf16 b) { return __builtin_bit_cast(float, (unsigned)b << 16); }
__device__ __forceinline__ float wave_sum(float v) {
#pragma unroll
    for (int o = 1; o < 64; o <<= 1) v += __shfl_xor(v, o);
    return v;
}
__device__ __forceinline__ float sigmoidf_(float v) { return 1.0f / (1.0f + __expf(-v)); }

static __device__ const float ROPE_INV[64] = {
1.000000000e+00f, 8.639884591e-01f, 7.464760542e-01f, 6.449466348e-01f, 5.572264791e-01f, 4.814372361e-01f, 4.159561992e-01f, 3.593813479e-01f, 3.105013072e-01f, 2.682695389e-01f, 2.317818105e-01f, 2.002568096e-01f, 1.730195731e-01f, 1.494868994e-01f, 1.291549653e-01f, 1.115883961e-01f, 9.641107172e-02f, 8.329805732e-02f, 7.196855545e-02f, 6.218000501e-02f, 5.372280627e-02f, 4.641588405e-02f, 4.010278732e-02f, 3.464834765e-02f, 2.993577160e-02f, 2.586415969e-02f, 2.234633639e-02f, 1.930697635e-02f, 1.668100432e-02f, 1.441219542e-02f, 1.245197095e-02f, 1.075835899e-02f, 9.295094758e-03f, 8.030855097e-03f, 6.938565988e-03f, 5.994841456e-03f, 5.179473665e-03f, 4.475004971e-03f, 3.866352839e-03f, 3.340484342e-03f, 2.886140021e-03f, 2.493591513e-03f, 2.154434333e-03f, 1.861406374e-03f, 1.608233550e-03f, 1.389495214e-03f, 1.200507861e-03f, 1.037224894e-03f, 8.961503627e-04f, 7.742635789e-04f, 6.689548027e-04f, 5.779691855e-04f, 4.993587499e-04f, 4.314401885e-04f, 3.727593576e-04f, 3.220597864e-04f, 2.782559022e-04f, 2.404099068e-04f, 2.077113895e-04f, 1.794602285e-04f, 1.550515735e-04f, 1.339627779e-04f, 1.157422885e-04f, 9.999999747e-05f };

struct Args {
    const float* in[22]; float* out; unsigned char* ws; int ph_lo, ph_hi;
};

__device__ __forceinline__ void p0_transpose_item(const float* W, int K, int N, bf16* WT, LAS float* scr, int item, int lane) {
    const int nblk = N / 32, kb = item / nblk, nb = item % nblk, k0 = 64 * kb, n0 = 32 * nb;
#pragma unroll 8
    for (int i = 0; i < 32; ++i) { const int kk = 2 * i + (lane >> 5); scr[kk * 33 + (lane & 31)] = W[(size_t)(k0 + kk) * N + n0 + (lane & 31)]; }
    LDS_WAIT(); asm volatile("" ::: "memory");
    const int c = lane & 7;
#pragma unroll
    for (int j = 0; j < 4; ++j) { const int n = (lane >> 3) + 8 * j; const LAS float* s = scr + (8 * c) * 33 + n;
        v4u o; o.x = pk2(s[0 * 33], s[1 * 33]); o.y = pk2(s[2 * 33], s[3 * 33]); o.z = pk2(s[4 * 33], s[5 * 33]); o.w = pk2(s[6 * 33], s[7 * 33]);
        *(v4u*)(WT + (size_t)(n0 + n) * K + k0 + 8 * c) = o; }
    LDS_WAIT(); asm volatile("" ::: "memory");
}
__device__ __forceinline__ void cvt_rows(const float* src, bf16* dst, int n8, int gt, int NT) {
    for (int i = gt; i < n8; i += NT) {
        const f32x4 a = *(const f32x4*)(src + (size_t)i * 8), b = *(const f32x4*)(src + (size_t)i * 8 + 4);
        v4u o; o.x = pk2(a.x, a.y); o.y = pk2(a.z, a.w); o.z = pk2(b.x, b.y); o.w = pk2(b.z, b.w);
        *(v4u*)(dst + (size_t)i * 8) = o; }
}
__device__ __forceinline__ void p0_prologue(const Args& A, LAS unsigned char* lds, int vcu, int G, int tid, int wave, int lane) {
    unsigned char* ws = A.ws;
    LAS float* scr = (LAS float*)(lds + wave * 16384);
    const int gw = vcu * NWAVES + wave, NGW = G * NWAVES;
    constexpr int I_IN = 16 * 96, I_SQ = 16 * 32, I_UP = 16 * 128, I_DN = 64 * 32;
    constexpr int NITEMS = I_IN + 5 * I_SQ + I_UP + I_DN;
    for (int it = gw; it < NITEMS; it += NGW) {
        int r = it;
        if (r < I_IN) { p0_transpose_item(A.in[2], 1024, 3072, (bf16*)(ws + WS_WIN), scr, r, lane); continue; } r -= I_IN;
        if (r < I_SQ) { p0_transpose_item(A.in[9], 1024, 1024, (bf16*)(ws + WS_WOUT), scr, r, lane); continue; } r -= I_SQ;
        if (r < I_SQ) { p0_transpose_item(A.in[12], 1024, 1024, (bf16*)(ws + WS_WXQ), scr, r, lane); continue; } r -= I_SQ;
        if (r < I_SQ) { p0_transpose_item(A.in[13], 1024, 1024, (bf16*)(ws + WS_WXK), scr, r, lane); continue; } r -= I_SQ;
        if (r < I_SQ) { p0_transpose_item(A.in[14], 1024, 1024, (bf16*)(ws + WS_WXV), scr, r, lane); continue; } r -= I_SQ;
        if (r < I_SQ) { p0_transpose_item(A.in[15], 1024, 1024, (bf16*)(ws + WS_WXO), scr, r, lane); continue; } r -= I_SQ;
        if (r < I_UP) { p0_transpose_item(A.in[18], 1024, 4096, (bf16*)(ws + WS_WUP), scr, r, lane); continue; } r -= I_UP;
        p0_transpose_item(A.in[19], 4096, 1024, (bf16*)(ws + WS_WDN), scr, r, lane);
    }
    const int gt = vcu * 512 + tid, NT = G * 512;
    cvt_rows(A.in[0], (bf16*)(ws + WS_XB), T * DM / 8, gt, NT);
    cvt_rows(A.in[1], (bf16*)(ws + WS_MEMB), MEMT * DM / 8, gt, NT);
    float* cosT = (float*)(ws + WS_ROPE); float* sinT = cosT + SEQ * 64;
    for (int i = gt; i < SEQ * 64; i += NT) {
        const int pos = i >> 6, j = i & 63;
        const float ang = (float)pos * ROPE_INV[j];
        const double a = (double)ang; const double kq = rint(a * 0.63661977236758134308);
        const double r = a - kq * 1.57079632679489661923; const double r2 = r * r;
        double s = -2.5052108385441718775e-08; s = s * r2 + 2.7557319223985890653e-06; s = s * r2 - 1.9841269841269841270e-04; s = s * r2 + 8.3333333333333333333e-03; s = s * r2 - 1.6666666666666666667e-01; s = s * r2 * r + r;
        double c = 2.0876756987868098979e-09; c = c * r2 - 2.7557319223985890653e-07; c = c * r2 + 2.4801587301587301587e-05; c = c * r2 - 1.3888888888888888889e-03; c = c * r2 + 4.1666666666666666667e-02; c = c * r2 - 0.5; c = c * r2 + 1.0;
        const int q = ((int)kq) & 3;
        const double sv = (q == 0) ? s : (q == 1) ? c : (q == 2) ? -s : -c;
        const double cv = (q == 0) ? c : (q == 1) ? -s : (q == 2) ? -c : s;
        cosT[i] = (float)cv; sinT[i] = (float)sv;
    }
}

__device__ __forceinline__ void ln_phase(float* io, const float* g, const float* b, bf16* ob, int vcu, int G, int wave, int lane) {
    const int gw = vcu * NWAVES + wave, NGW = G * NWAVES;
    f32x4 gv[4], bv[4];
#pragma unroll
    for (int j = 0; j < 4; ++j) { gv[j] = *(const f32x4*)(g + 4 * (lane + 64 * j)); bv[j] = *(const f32x4*)(b + 4 * (lane + 64 * j)); }
    for (int m = gw; m < T; m += NGW) {
        f32x4* xr = (f32x4*)(io + (size_t)m * DM) + lane;
        f32x4 v[4]; float s = 0.f;
#pragma unroll
        for (int j = 0; j < 4; ++j) { v[j] = xr[64 * j]; s += (v[j].x + v[j].y) + (v[j].z + v[j].w); }
        const float mean = wave_sum(s) * (1.f / DM); float s2 = 0.f;
#pragma unroll
        for (int j = 0; j < 4; ++j) { v[j] = v[j] - mean; s2 += (v[j].x * v[j].x + v[j].y * v[j].y) + (v[j].z * v[j].z + v[j].w * v[j].w); }
        const float rstd = 1.f / sqrtf(wave_sum(s2) * (1.f / DM) + LN_EPS);
#pragma unroll
        for (int j = 0; j < 4; ++j) { v[j] = v[j] * rstd * gv[j] + bv[j]; xr[64 * j] = v[j]; }
        if (ob) { unsigned long long* o8 = (unsigned long long*)(ob + (size_t)m * DM) + lane;
#pragma unroll
            for (int j = 0; j < 4; ++j) o8[64 * j] = (unsigned long long)pk2(v[j].x, v[j].y) | ((unsigned long long)pk2(v[j].z, v[j].w) << 32); }
    }
}

__device__ __forceinline__ void conv_phase(const Args& A, LAS unsigned char* lds, int vcu, int G, int tid, int wave, int lane) {
    const bf16* h = (const bf16*)(A.ws + WS_H); bf16* cat = (bf16*)(A.ws + WS_CAT);
    const float* conv_w = A.in[3]; const int c = tid;
    float w[CKW];
#pragma unroll
    for (int j = 0; j < CKW; ++j) w[j] = conv_w[j * CW + c];
    const float bias = A.in[4][c];
    LAS float* ybuf = (LAS float*)lds;
    f32x4 g0 = *(const f32x4*)(A.in[5] + 8 * lane), g1 = *(const f32x4*)(A.in[5] + 8 * lane + 4);
    f32x4 b0 = *(const f32x4*)(A.in[6] + 8 * lane), b1 = *(const f32x4*)(A.in[6] + 8 * lane + 4);
    for (int unit = vcu; unit < NB * (SEQ / 32); unit += G) {
        const int b = unit / (SEQ / 32), t0 = (unit % (SEQ / 32)) * 32;
        float u[62];
        const bf16* hp = h + ((long)b * SEQ + t0 - 30) * (long)INC + c;
#pragma unroll
        for (int i = 0; i < 62; ++i) {
            if (t0 - 30 + i >= 0) { const float a = bf1(hp[(long)i * INC + COL_A]), bb = bf1(hp[(long)i * INC + COL_B]); u[i] = a * sigmoidf_(bb); }
            else u[i] = 0.f;
        }
#pragma unroll
        for (int tt = 0; tt < 32; ++tt) { float y = bias;
#pragma unroll
            for (int j = 0; j < CKW; ++j) y += w[j] * u[tt + j];
            ybuf[tt * CW + c] = y; }
        __syncthreads();
#pragma unroll
        for (int k = 0; k < 4; ++k) { const int tt = 4 * wave + k;
            const LAS f32x4* yr = (const LAS f32x4*)(ybuf + tt * CW) + 2 * lane;
            f32x4 v0 = yr[0], v1 = yr[1];
            const float mean = wave_sum((v0.x + v0.y) + (v0.z + v0.w) + (v1.x + v1.y) + (v1.z + v1.w)) * (1.f / CW);
            v0 = v0 - mean; v1 = v1 - mean;
            const float var = wave_sum((v0.x * v0.x + v0.y * v0.y) + (v0.z * v0.z + v0.w * v0.w) + (v1.x * v1.x + v1.y * v1.y) + (v1.z * v1.z + v1.w * v1.w)) * (1.f / CW);
            const float rstd = 1.f / sqrtf(var + LN_EPS);
            v0 = v0 * rstd * g0 + b0; v1 = v1 * rstd * g1 + b1;
#pragma unroll
            for (int e = 0; e < 4; ++e) { v0[e] = v0[e] * sigmoidf_(v0[e]); v1[e] = v1[e] * sigmoidf_(v1[e]); }
            v4u o; o.x = pk2(v0.x, v0.y); o.y = pk2(v0.z, v0.w); o.z = pk2(v1.x, v1.y); o.w = pk2(v1.z, v1.w);
            *(v4u*)(cat + ((size_t)b * SEQ + t0 + tt) * DM + 8 * lane) = o; }
        __syncthreads();
    }
}

constexpr int RP = 136;
template <bool TRANSPOSED, bool KDEC>
__device__ __forceinline__ void stage_rot(const bf16* h, size_t row0, int col0, int pos0, const float* cosT, const float* sinT, float sc, float lg2, LAS bf16* dst, int tid) {
#pragma unroll
    for (int k = 0; k < 2; ++k) {
        const int item = tid + 512 * k; const int m = item & 127, i = item >> 7;
        const bf16* hp = h + (row0 + m) * INC + col0 + 8 * i;
        const v4u k1 = *(const v4u*)hp, k2 = *(const v4u*)(hp + 64);
        const float* cp = cosT + (size_t)(pos0 + m) * 64 + 8 * i; const float* sp = sinT + (size_t)(pos0 + m) * 64 + 8 * i;
        const f32x4 c0 = *(const f32x4*)cp, c1 = *(const f32x4*)(cp + 4), s0 = *(const f32x4*)sp, s1 = *(const f32x4*)(sp + 4);
        float a[8], bq[8], cs[8], sn[8];
        a[0] = bflo(k1.x); a[1] = bfhi(k1.x); a[2] = bflo(k1.y); a[3] = bfhi(k1.y); a[4] = bflo(k1.z); a[5] = bfhi(k1.z); a[6] = bflo(k1.w); a[7] = bfhi(k1.w);
        bq[0] = bflo(k2.x); bq[1] = bfhi(k2.x); bq[2] = bflo(k2.y); bq[3] = bfhi(k2.y); bq[4] = bflo(k2.z); bq[5] = bfhi(k2.z); bq[6] = bflo(k2.w); bq[7] = bfhi(k2.w);
        cs[0] = c0.x; cs[1] = c0.y; cs[2] = c0.z; cs[3] = c0.w; cs[4] = c1.x; cs[5] = c1.y; cs[6] = c1.z; cs[7] = c1.w;
        sn[0] = s0.x; sn[1] = s0.y; sn[2] = s0.z; sn[3] = s0.w; sn[4] = s1.x; sn[5] = s1.y; sn[6] = s1.z; sn[7] = s1.w;
        float scl = sc; if (KDEC) scl *= exp2f(lg2 * (float)(127 - m));
        float o1[8], o2[8];
#pragma unroll
        for (int j = 0; j < 8; ++j) { o1[j] = (a[j] * cs[j] - bq[j] * sn[j]) * scl; o2[j] = (bq[j] * cs[j] + a[j] * sn[j]) * scl; }
        if (TRANSPOSED) {
#pragma unroll
            for (int j = 0; j < 8; ++j) { dst[(8 * i + j) * RP + m] = (bf16)f2bf(o1[j]); dst[(64 + 8 * i + j) * RP + m] = (bf16)f2bf(o2[j]); }
        } else {
            v4u w1, w2; w1.x = pk2(o1[0], o1[1]); w1.y = pk2(o1[2], o1[3]); w1.z = pk2(o1[4], o1[5]); w1.w = pk2(o1[6], o1[7]);
            w2.x = pk2(o2[0], o2[1]); w2.y = pk2(o2[2], o2[3]); w2.z = pk2(o2[4], o2[5]); w2.w = pk2(o2[6], o2[7]);
            *(LAS v4u*)(dst + m * RP + 8 * i) = w1; *(LAS v4u*)(dst + m * RP + 64 + 8 * i) = w2;
        }
    }
}
__device__ __forceinline__ void stage_vT(const bf16* h, size_t row0, int col0, LAS bf16* dst, int tid) {
#pragma unroll
    for (int k = 0; k < 4; ++k) {
        const int item = tid + 512 * k; const int m = item & 127, i = item >> 7;
        const v4u v = *(const v4u*)(h + (row0 + m) * INC + col0 + 8 * i);
        LAS bf16* d = dst + (8 * i) * RP + m;
        d[0 * RP] = (bf16)(v.x & 0xffffu); d[1 * RP] = (bf16)(v.x >> 16); d[2 * RP] = (bf16)(v.y & 0xffffu); d[3 * RP] = (bf16)(v.y >> 16);
        d[4 * RP] = (bf16)(v.z & 0xffffu); d[5 * RP] = (bf16)(v.z >> 16); d[6 * RP] = (bf16)(v.w & 0xffffu); d[7 * RP] = (bf16)(v.w >> 16);
    }
}
__device__ __forceinline__ float head_lg2(int hd) { return log2f(1.0f - exp2f(-5.0f - (float)hd)); }

__device__ __forceinline__ void ret_kv_phase(const Args& A, LAS unsigned char* lds, int vcu, int G, int tid, int wave, int lane) {
    const bf16* h = (const bf16*)(A.ws + WS_H); float* KV = (float*)(A.ws + WS_KV);
    const float* cosT = (const float*)(A.ws + WS_ROPE); const float* sinT = cosT + SEQ * 64;
    LAS bf16* KT = (LAS bf16*)lds; LAS bf16* VT = KT + 128 * RP;
    const int fr = lane & 15, fq = lane >> 4;
    for (int unit = vcu; unit < NB * RH * NCH; unit += G) {
        const int c = unit % NCH, hd = (unit / NCH) % RH, b = unit / (NCH * RH);
        const size_t row0 = (size_t)b * SEQ + c * RC;
        stage_rot<true, true>(h, row0, COL_K + hd * RD, c * RC, cosT, sinT, 1.0f, head_lg2(hd), KT, tid);
        stage_vT(h, row0, COL_V + hd * RD, VT, tid);
        __syncthreads();
        bf16x8 af[4];
#pragma unroll
        for (int km = 0; km < 4; ++km) af[km] = *(const LAS bf16x8*)(KT + (16 * wave + fr) * RP + 8 * fq + 32 * km);
        float* outp = KV + (size_t)unit * (RD * RD);
#pragma unroll
        for (int et = 0; et < 8; ++et) { f32x4 acc = {0.f, 0.f, 0.f, 0.f};
#pragma unroll
            for (int km = 0; km < 4; ++km) { const bf16x8 bfr = *(const LAS bf16x8*)(VT + (16 * et + fr) * RP + 8 * fq + 32 * km);
                acc = __builtin_amdgcn_mfma_f32_16x16x32_bf16(af[km], bfr, acc, 0, 0, 0); }
            *(f32x4*)(outp + (16 * et + fr) * RD + 16 * wave + 4 * fq) = acc; }
        __syncthreads();
    }
}
__device__ __forceinline__ void ret_scan_phase(const Args& A, int vcu, int G, int tid) {
    const float* KV = (const float*)(A.ws + WS_KV); bf16* SB = (bf16*)(A.ws + WS_SBF);
    const int gt = vcu * 512 + tid, NT = G * 512;
    for (int idx = gt; idx < NB * RH * (RD * RD / 4); idx += NT) {
        const int bh = idx >> 12, e4 = idx & 4095, hd = bh & 3;
        const float gC = exp2f(head_lg2(hd) * 128.0f);
        f32x4 st = {0.f, 0.f, 0.f, 0.f};
        const float* kp = KV + (size_t)bh * NCH * (RD * RD) + 4 * e4; bf16* sp = SB + (size_t)bh * NCH * (RD * RD) + 4 * e4;
#pragma unroll 8
        for (int c = 0; c < NCH; ++c) {
            v2u o; o.x = pk2(st.x, st.y); o.y = pk2(st.z, st.w); *(v2u*)(sp + (size_t)c * (RD * RD)) = o;
            const f32x4 kv = *(const f32x4*)(kp + (size_t)c * (RD * RD)); st = st * gC + kv; }
    }
}
__device__ __forceinline__ void ret_out_phase(const Args& A, LAS unsigned char* lds, int vcu, int G, int tid, int wave, int lane) {
    const bf16* h = (const bf16*)(A.ws + WS_H); const bf16* SB = (const bf16*)(A.ws + WS_SBF); bf16* cat = (bf16*)(A.ws + WS_CAT);
    const float* cosT = (const float*)(A.ws + WS_ROPE); const float* sinT = cosT + SEQ * 64;
    const float* gng = A.in[7]; const float* gnb = A.in[8];
    LAS bf16* Qs = (LAS bf16*)lds; LAS bf16* Ks = Qs + 128 * RP; LAS bf16* VT = Ks + 128 * RP; LAS bf16* ST = VT + 128 * RP;
    const int fr = lane & 15, fq = lane >> 4;
    for (int unit = vcu; unit < NB * RH * NCH; unit += G) {
        const int c = unit % NCH, hd = (unit / NCH) % RH, b = unit / (NCH * RH);
        const size_t row0 = (size_t)b * SEQ + c * RC; const float lg2 = head_lg2(hd);
        stage_rot<false, false>(h, row0, COL_Q + hd * RD, c * RC, cosT, sinT, 0.08838834764831845f, 0.f, Qs, tid);
        stage_rot<false, false>(h, row0, COL_K + hd * RD, c * RC, cosT, sinT, 1.0f, 0.f, Ks, tid);
        stage_vT(h, row0, COL_V + hd * RD, VT, tid);
        { const bf16* sp = SB + (size_t)unit * (RD * RD);
#pragma unroll
          for (int k = 0; k < 4; ++k) { const int item = tid + 512 * k; const int e = item >> 4, i = item & 15;
              *(LAS v4u*)(ST + e * RP + 8 * i) = *(const v4u*)(sp + e * RD + 8 * i); } }
        __syncthreads();
        bf16x8 qf[4];
#pragma unroll
        for (int kd = 0; kd < 4; ++kd) qf[kd] = *(const LAS bf16x8*)(Qs + (16 * wave + fr) * RP + 8 * fq + 32 * kd);
        v2u pk[8];
        const int n = 16 * wave + fr;
#pragma unroll
        for (int mt = 0; mt < 8; ++mt) {
            if (mt <= wave) {
                f32x4 s = {0.f, 0.f, 0.f, 0.f};
#pragma unroll
                for (int kd = 0; kd < 4; ++kd) { const bf16x8 kf = *(const LAS bf16x8*)(Ks + (16 * mt + fr) * RP + 8 * fq + 32 * kd);
                    s = __builtin_amdgcn_mfma_f32_16x16x32_bf16(kf, qf[kd], s, 0, 0, 0); }
                float p[4];
#pragma unroll
                for (int r = 0; r < 4; ++r) { const int m = 16 * mt + 4 * fq + r; const int rel = n - m; p[r] = (rel >= 0) ? s[r] * exp2f(lg2 * (float)rel) : 0.f; }
                pk[mt].x = pk2(p[0], p[1]); pk[mt].y = pk2(p[2], p[3]);
            } else { pk[mt].x = 0u; pk[mt].y = 0u; }
        }
        f32x4 yi[8], yc[8];
#pragma unroll
        for (int et = 0; et < 8; ++et) { yi[et] = (f32x4){0.f, 0.f, 0.f, 0.f}; yc[et] = (f32x4){0.f, 0.f, 0.f, 0.f}; }
#pragma unroll
        for (int kt = 0; kt < 4; ++kt) {
            if (2 * kt <= wave) {
                bf16x8 pf = __builtin_bit_cast(bf16x8, (v4u){pk[2 * kt].x, pk[2 * kt].y, pk[2 * kt + 1].x, pk[2 * kt + 1].y});
#pragma unroll
                for (int et = 0; et < 8; ++et) {
                    const LAS bf16* vp = VT + (16 * et + fr) * RP + 32 * kt + 4 * fq;
                    const v2u v0 = *(const LAS v2u*)vp, v1 = *(const LAS v2u*)(vp + 16);
                    const bf16x8 vf = __builtin_bit_cast(bf16x8, (v4u){v0.x, v0.y, v1.x, v1.y});
                    yi[et] = __builtin_amdgcn_mfma_f32_16x16x32_bf16(vf, pf, yi[et], 0, 0, 0); }
            }
        }
#pragma unroll
        for (int kd = 0; kd < 4; ++kd)
#pragma unroll
            for (int et = 0; et < 8; ++et) { const bf16x8 sf = *(const LAS bf16x8*)(ST + (16 * et + fr) * RP + 8 * fq + 32 * kd);
                yc[et] = __builtin_amdgcn_mfma_f32_16x16x32_bf16(sf, qf[kd], yc[et], 0, 0, 0); }
        const float qdec = exp2f(lg2 * (float)(n + 1));
        float s1 = 0.f;
#pragma unroll
        for (int et = 0; et < 8; ++et) { yi[et] = yi[et] + yc[et] * qdec; s1 += (yi[et].x + yi[et].y) + (yi[et].z + yi[et].w); }
        s1 += __shfl_xor(s1, 16); s1 += __shfl_xor(s1, 32);
        const float mean = s1 * (1.f / RD); float s2 = 0.f;
#pragma unroll
        for (int et = 0; et < 8; ++et) { yi[et] = yi[et] - mean; s2 += (yi[et].x * yi[et].x + yi[et].y * yi[et].y) + (yi[et].z * yi[et].z + yi[et].w * yi[et].w); }
        s2 += __shfl_xor(s2, 16); s2 += __shfl_xor(s2, 32);
        const float rstd = 1.f / sqrtf(s2 * (1.f / RD) + LN_EPS);
        const size_t row = row0 + n;
#pragma unroll
        for (int et = 0; et < 8; ++et) { const int e = 16 * et + 4 * fq;
            const f32x4 gg = *(const f32x4*)(gng + hd * RD + e), gb = *(const f32x4*)(gnb + hd * RD + e);
            const v2u gw = *(const v2u*)(h + row * INC + COL_G + hd * RD + e);
            const float g0 = bflo(gw.x), g1 = bfhi(gw.x), g2 = bflo(gw.y), g3 = bfhi(gw.y);
            f32x4 o = yi[et] * rstd * gg + gb;
            o.x *= g0 * sigmoidf_(g0); o.y *= g1 * sigmoidf_(g1); o.z *= g2 * sigmoidf_(g2); o.w *= g3 * sigmoidf_(g3);
            v2u w; w.x = pk2(o.x, o.y); w.y = pk2(o.z, o.w);
            *(v2u*)(cat + row * DM + CW + hd * RD + e) = w; }
        __syncthreads();
    }
}

constexpr int XP = 264;
__device__ __forceinline__ void xattn_phase(const Args& A, LAS unsigned char* lds, int vcu, int G, int tid, int wave, int lane) {
    bf16* QO = (bf16*)(A.ws + WS_CAT); const bf16* KM = (const bf16*)(A.ws + WS_KM); const bf16* VTm = (const bf16*)(A.ws + WS_VT);
    LAS bf16* L = (LAS bf16*)lds;
    const int fr = lane & 15, fq = lane >> 4;
    constexpr float SC = 0.0625f * 1.4426950408889634f;
    for (int unit = vcu; unit < NB * XH * (SEQ / 128); unit += G) {
        const int qb = unit % (SEQ / 128), hd = (unit / (SEQ / 128)) % XH, b = unit / ((SEQ / 128) * XH);
#pragma unroll
        for (int k = 0; k < 16; ++k) { const int item = tid + 512 * k; const int m = item >> 5, i = item & 31;
            *(LAS v4u*)(L + m * XP + 8 * i) = *(const v4u*)(KM + ((size_t)b * NMEM + m) * DM + hd * XD + 8 * i); }
        const size_t row = (size_t)b * SEQ + qb * 128 + 16 * wave + fr;
        bf16x8 qf[8];
#pragma unroll
        for (int kd = 0; kd < 8; ++kd) qf[kd] = *(const bf16x8*)(QO + row * DM + hd * XD + 8 * fq + 32 * kd);
        __syncthreads();
        f32x4 s[16];
#pragma unroll
        for (int mt = 0; mt < 16; ++mt) { s[mt] = (f32x4){0.f, 0.f, 0.f, 0.f};
#pragma unroll
            for (int kd = 0; kd < 8; ++kd) { const bf16x8 kf = *(const LAS bf16x8*)(L + (16 * mt + fr) * XP + 8 * fq + 32 * kd);
                s[mt] = __builtin_amdgcn_mfma_f32_16x16x32_bf16(kf, qf[kd], s[mt], 0, 0, 0); } }
        float mx = -3.0e38f;
#pragma unroll
        for (int mt = 0; mt < 16; ++mt) mx = fmaxf(mx, fmaxf(fmaxf(s[mt].x, s[mt].y), fmaxf(s[mt].z, s[mt].w)));
        mx = fmaxf(mx, __shfl_xor(mx, 16)); mx = fmaxf(mx, __shfl_xor(mx, 32));
        float sum = 0.f; v2u pk[16];
#pragma unroll
        for (int mt = 0; mt < 16; ++mt) { f32x4 p;
#pragma unroll
            for (int r = 0; r < 4; ++r) p[r] = exp2f((s[mt][r] - mx) * SC);
            sum += (p.x + p.y) + (p.z + p.w); pk[mt].x = pk2(p.x, p.y); pk[mt].y = pk2(p.z, p.w); }
        sum += __shfl_xor(sum, 16); sum += __shfl_xor(sum, 32);
        const float inv = 1.0f / sum;
        __syncthreads();
#pragma unroll
        for (int k = 0; k < 16; ++k) { const int item = tid + 512 * k; const int d = item >> 5, i = item & 31;
            *(LAS v4u*)(L + d * XP + 8 * i) = *(const v4u*)(VTm + ((size_t)hd * XD + d) * MEMT + b * NMEM + 8 * i); }
        __syncthreads();
        f32x4 o[16];
#pragma unroll
        for (int dt = 0; dt < 16; ++dt) o[dt] = (f32x4){0.f, 0.f, 0.f, 0.f};
#pragma unroll
        for (int kt = 0; kt < 8; ++kt) {
            const bf16x8 pf = __builtin_bit_cast(bf16x8, (v4u){pk[2 * kt].x, pk[2 * kt].y, pk[2 * kt + 1].x, pk[2 * kt + 1].y});
#pragma unroll
            for (int dt = 0; dt < 16; ++dt) { const LAS bf16* vp = L + (16 * dt + fr) * XP + 32 * kt + 4 * fq;
                const v2u v0 = *(const LAS v2u*)vp, v1 = *(const LAS v2u*)(vp + 16);
                const bf16x8 vf = __builtin_bit_cast(bf16x8, (v4u){v0.x, v0.y, v1.x, v1.y});
                o[dt] = __builtin_amdgcn_mfma_f32_16x16x32_bf16(vf, pf, o[dt], 0, 0, 0); } }
#pragma unroll
        for (int dt = 0; dt < 16; ++dt) { const f32x4 v = o[dt] * inv; v2u w; w.x = pk2(v.x, v.y); w.y = pk2(v.z, v.w);
            *(v2u*)(QO + row * DM + hd * XD + 16 * dt + 4 * fq) = w; }
        __syncthreads();
    }
}

#define XB_TMO      128
#define XB_XCNT(j)  (256  + 64 * (j))
#define XB_XSUB(j)  (1280 + 64 * (j))
#define XB_XGEN(j)  (2304 + 64 * (j))
#define XB_TOP      3328
#define XB_TOPGEN   3392
#define XCD_BAR_WORDS 3456
#define XB_SPIN_CAP (1u << 18)

__device__ __forceinline__ unsigned xb_ld(unsigned* p)              { return __hip_atomic_load(p, __ATOMIC_RELAXED, __HIP_MEMORY_SCOPE_AGENT); }
__device__ __forceinline__ unsigned xb_add(unsigned* p, unsigned v) { return __hip_atomic_fetch_add(p, v, __ATOMIC_RELAXED, __HIP_MEMORY_SCOPE_AGENT); }
__device__ __forceinline__ unsigned xb_xcc_id() { return (unsigned)__builtin_amdgcn_s_getreg((3 << 11) | 20) & 0xFu; }
#define XB_SPIN(cond, bar) do { unsigned _sp = 0; while (cond) { __builtin_amdgcn_s_sleep(1); \
    if ((++_sp & 255u) == 0u) { if (xb_ld(&(bar)[XB_TMO])) break; if (_sp > XB_SPIN_CAP) { atomicAdd(&(bar)[XB_TMO], 1u); break; } } } } while (0)

struct XcdBarrier {
    unsigned* bar; unsigned x;
    volatile LAS unsigned* st;
};

__device__ __forceinline__ XcdBarrier xcd_barrier_post(unsigned* bar, volatile LAS unsigned* st) {
    XcdBarrier b; b.bar = bar; b.x = xb_xcc_id(); b.st = st;
    if (threadIdx.x == 0) (void)xb_add(&bar[XB_XCNT(b.x)], 1u);
    return b;
}
__device__ __forceinline__ void xcd_barrier_complete(unsigned* bar, unsigned x, unsigned& nloc, unsigned& nx) {
    const unsigned G = gridDim.x * gridDim.y * gridDim.z;
    unsigned sum, cnt, mine, sp = 0u;
    for (;;) {
        sum = 0u; cnt = 0u; mine = 0u;
#pragma unroll
        for (unsigned j = 0; j < 16; ++j) { const unsigned c = xb_ld(&bar[XB_XCNT(j)]); sum += c; cnt += (c > 0u) ? 1u : 0u; mine = (j == x) ? c : mine; }
        if (sum == G) break;
        __builtin_amdgcn_s_sleep(1);
        if ((++sp & 255u) == 0u) { if (xb_ld(&bar[XB_TMO])) break; if (sp > XB_SPIN_CAP) { atomicAdd(&bar[XB_TMO], 1u); break; } }
    }
    nloc = mine > 0u ? mine : 1u; nx = cnt > 0u ? cnt : 1u;
}

__device__ __forceinline__ void xcd_barrier(const XcdBarrier& b) {
    asm volatile("s_waitcnt vmcnt(0)" ::: "memory");
    __syncthreads();
    if (threadIdx.x == 0) {
        unsigned* bar = b.bar;
        __builtin_amdgcn_s_waitcnt(0);
        unsigned nloc = b.st[0], nx = b.st[1];
        if (nloc == 0u) { xcd_barrier_complete(bar, b.x, nloc, nx); b.st[0] = nloc; b.st[1] = nx; }
        const unsigned old = xb_add(&bar[XB_XSUB(b.x)], 1u);
        const unsigned gen = old / nloc;
        if (old + 1u == (gen + 1u) * nloc) {
            __builtin_amdgcn_fence(__ATOMIC_RELEASE, "agent");
            asm volatile("s_waitcnt vmcnt(0)" ::: "memory");
            const unsigned og = xb_add(&bar[XB_TOP], 1u);
            const unsigned tg = og / nx;
            if (og + 1u == (tg + 1u) * nx) xb_add(&bar[XB_TOPGEN], 1u);
            else XB_SPIN(xb_ld(&bar[XB_TOPGEN]) == tg, bar);
            __builtin_amdgcn_fence(__ATOMIC_ACQUIRE, "agent");
            xb_add(&bar[XB_XGEN(b.x)], 1u);
            asm volatile("s_waitcnt vmcnt(0)" ::: "memory");
        } else {
            XB_SPIN(xb_ld(&bar[XB_XGEN(b.x)]) == gen, bar);
            __builtin_amdgcn_fence(__ATOMIC_ACQUIRE, "agent");
            asm volatile("s_waitcnt vmcnt(0)" ::: "memory");
        }
    }
    __syncthreads();
}

__global__ void __launch_bounds__(NWAVES * 64, 2) fwd_megakernel(Args args) {
    extern __shared__ __attribute__((aligned(16))) unsigned char lds_raw[];
    LAS unsigned char* lds = (LAS unsigned char*)lds_raw;
    const int tid = threadIdx.x, lane = tid & 63, wave = __builtin_amdgcn_readfirstlane(tid >> 6);
    const int G = gridDim.x; const int bx = blockIdx.x; const int vcu = (G % 8 == 0) ? (bx % 8) * (G / 8) + bx / 8 : bx;
    unsigned char* ws = args.ws;
    const int lo = args.ph_lo, hi = args.ph_hi;
    cg::grid_group grid = cg::this_grid();
    if (lo > 1000) grid.sync();
    volatile LAS unsigned* xst = (volatile LAS unsigned*)(lds + LDS_BYTES - 64);
    if (tid < 2) xst[tid] = 0u;
    __syncthreads();
    const XcdBarrier xbar = xcd_barrier_post((unsigned*)ws, xst);
#define IN(k) (lo <= (k) && (k) < hi)
#define SEAM(k) do { if (IN(k) && IN((k) + 1)) xcd_barrier(xbar); } while (0)
    bf16* XB = (bf16*)(ws + WS_XB); bf16* CAT = (bf16*)(ws + WS_CAT); bf16* H = (bf16*)(ws + WS_H); bf16* HID = (bf16*)(ws + WS_HID);

    if (IN(0)) { p0_prologue(args, lds, vcu, G, tid, wave, lane); __syncthreads(); }
    SEAM(0);
    if (IN(1)) {
        { pg8::Gemm g{(const bf16*)(ws + WS_MEMB), (const bf16*)(ws + WS_WXK), MEMT, DM, DM}; pg8::StaticOrder S; S.init(MEMT, DM, G, bx);
          pg8::EpiStoreBf16<0> E{(bf16*)(ws + WS_KM), DM};
          pg8::gemm_phase<pg8::EpiStoreBf16<0>, pg8::StaticOrder, true, true>(lds, g, S, E); }
        { pg8::Gemm g{(const bf16*)(ws + WS_WXV), (const bf16*)(ws + WS_MEMB), DM, MEMT, DM}; pg8::StaticOrder S; S.init(DM, MEMT, G, (bx + G - 32) % G);
          pg8::EpiStoreBf16<0> E{(bf16*)(ws + WS_VT), MEMT};
          pg8::gemm_phase<pg8::EpiStoreBf16<0>, pg8::StaticOrder, true, true>(lds, g, S, E); }
        { pg8::Gemm g{XB, (const bf16*)(ws + WS_WIN), T, INC, DM}; pg8::StaticOrder S; S.init(T, INC, G, bx);
          pg8::EpiStoreBf16<0> E{H, INC};
          pg8::gemm_phase<pg8::EpiStoreBf16<0>, pg8::StaticOrder, true, true>(lds, g, S, E); }
    }
    SEAM(1);
    if (IN(2)) { conv_phase(args, lds, vcu, G, tid, wave, lane); ret_kv_phase(args, lds, vcu, G, tid, wave, lane); }
    SEAM(2);
    if (IN(3)) ret_scan_phase(args, vcu, G, tid);
    SEAM(3);
    if (IN(4)) ret_out_phase(args, lds, vcu, G, tid, wave, lane);
    SEAM(4);
    if (IN(5)) {
        pg8::Gemm g{CAT, (const bf16*)(ws + WS_WOUT), T, DM, DM}; pg8::StaticOrder S; S.init(T, DM, G, bx);
        pg8::EpiResF32 E{args.in[0], args.out, DM, DN_ALPHA};
        pg8::gemm_phase<pg8::EpiResF32, pg8::StaticOrder, true, true>(lds, g, S, E);
    }
    SEAM(5);
    if (IN(6)) ln_phase(args.out, args.in[10], args.in[11], XB, vcu, G, wave, lane);
    SEAM(6);
    if (IN(7)) {
        pg8::Gemm g{XB, (const bf16*)(ws + WS_WXQ), T, DM, DM}; pg8::StaticOrder S; S.init(T, DM, G, bx);
        pg8::EpiStoreBf16<0> E{CAT, DM};
        pg8::gemm_phase<pg8::EpiStoreBf16<0>, pg8::StaticOrder, true, true>(lds, g, S, E);
    }
    SEAM(7);
    if (IN(8)) xattn_phase(args, lds, vcu, G, tid, wave, lane);
    SEAM(8);
    if (IN(9)) {
        pg8::Gemm g{CAT, (const bf16*)(ws + WS_WXO), T, DM, DM}; pg8::StaticOrder S; S.init(T, DM, G, bx);
        pg8::EpiResF32 E{args.out, args.out, DM, DN_ALPHA};
        pg8::gemm_phase<pg8::EpiResF32, pg8::StaticOrder, true, true>(lds, g, S, E);
    }
    SEAM(9);
    if (IN(10)) ln_phase(args.out, args.in[16], args.in[17], XB, vcu, G, wave, lane);
    SEAM(10);
    if (IN(11)) {
        pg8::Gemm g{XB, (const bf16*)(ws + WS_WUP), T, FF, DM}; pg8::StaticOrder S; S.init(T, FF, G, bx);
        pg8::EpiStoreBf16<1> E{HID, FF};
        pg8::gemm_phase<pg8::EpiStoreBf16<1>, pg8::StaticOrder, true, true>(lds, g, S, E);
    }
    SEAM(11);
    if (IN(12)) {
        pg8::Gemm g{HID, (const bf16*)(ws + WS_WDN), T, DM, FF}; pg8::StaticOrder S; S.init(T, DM, G, bx);
        pg8::EpiResF32 E{args.out, args.out, DM, DN_ALPHA};
        pg8::gemm_phase<pg8::EpiResF32, pg8::StaticOrder, true, true>(lds, g, S, E);
    }
    SEAM(12);
    if (IN(13)) ln_phase(args.out, args.in[20], args.in[21], nullptr, vcu, G, wave, lane);
#undef IN
#undef SEAM
}

#ifndef MK_MULTI
#define MK_MULTI 0
#endif
extern "C" void kernel_launch(void* const* d_in, const int* in_sizes, int n_in, void* d_out, int out_size, void* d_ws, size_t ws_size, hipStream_t stream) {
    static int grid = 0;
    if (grid == 0) {
        if (n_in != 22 || out_size != T * DM || ws_size < WS_END) { fprintf(stderr, "kernel_launch: unexpected problem (n_in %d, out %d, ws %zu)\n", n_in, out_size, ws_size); grid = -1; return; }
        int dev = 0, cus = 0, per_cu = 0;
        if (hipGetDevice(&dev) != hipSuccess || hipDeviceGetAttribute(&cus, hipDeviceAttributeMultiprocessorCount, dev) != hipSuccess) { grid = -1; return; }
        if (hipFuncSetAttribute((const void*)fwd_megakernel, hipFuncAttributeMaxDynamicSharedMemorySize, LDS_BYTES) != hipSuccess) { fprintf(stderr, "kernel_launch: hipFuncSetAttribute failed\n"); grid = -1; return; }
        if (hipOccupancyMaxActiveBlocksPerMultiprocessor(&per_cu, (const void*)fwd_megakernel, NWAVES * 64, LDS_BYTES) != hipSuccess || per_cu < 1) { fprintf(stderr, "kernel_launch: occupancy query gave %d\n", per_cu); (void)hipGetLastError(); per_cu = 1; }
        grid = cus * (per_cu > 1 ? 1 : per_cu);
    }
    if (grid < 0) return;
    if (hipMemsetAsync(d_ws, 0, 16384, stream) != hipSuccess) { fprintf(stderr, "kernel_launch: memset failed\n"); return; }
    Args a{};
    for (int i = 0; i < 22; ++i) a.in[i] = (const float*)d_in[i];
    a.out = (float*)d_out; a.ws = (unsigned char*)d_ws;
#if MK_MULTI
    for (int p = 0; p < NPHASE; ++p) {
        a.ph_lo = p; a.ph_hi = p + 1;
        void* kargs[] = {&a};
        hipError_t e = hipLaunchCooperativeKernel((const void*)fwd_megakernel, dim3(grid), dim3(NWAVES * 64), kargs, LDS_BYTES, stream);
        if (e != hipSuccess) { fprintf(stderr, "kernel_launch: launch of phase %d failed: %s\n", p, hipGetErrorString(e)); break; }
    }
#else
    a.ph_lo = 0; a.ph_hi = NPHASE;
    void* kargs[] = {&a};
    hipError_t e = hipLaunchCooperativeKernel((const void*)fwd_megakernel, dim3(grid), dim3(NWAVES * 64), kargs, LDS_BYTES, stream);
    if (e != hipSuccess) fprintf(stderr, "kernel_launch: cooperative launch failed: %s (grid %d)\n", hipGetErrorString(e), grid);
#endif
}
```

```cpp
#include <hip/hip_runtime.h>
#include <hip/hip_cooperative_groups.h>
#include <cstdio>
#include <cstdint>
namespace cg = cooperative_groups;
namespace pg8 {
#define PG8_LAS __attribute__((address_space(3)))
typedef unsigned short bf16_t;
typedef short bf16x8 __attribute__((ext_vector_type(8)));
typedef float f32x4 __attribute__((ext_vector_type(4)));
typedef unsigned u32x4 __attribute__((ext_vector_type(4)));
constexpr int BM = 256, BK = 64, HALF = 128, HTB = HALF * BK * 2  , STAGE_BYTES = 8 * HTB, NXCD = 8, WGM = 8;

__host__ __device__ __forceinline__ int lds_byte(int r, int c) { const int st = (r >> 4) * 2 + (c >> 5), rr = r & 15, cc = c & 31, ob = rr * 64 + cc * 2; return st * 1024 + (ob ^ (((ob >> 9) & 1) << 5)); }
__host__ __device__ __forceinline__ void stage_rc(int b, int& R, int& C) { const int st = b / 1024, sb = b % 1024, swz = sb ^ (((sb >> 9) & 1) << 5); R = (st >> 1) * 16 + swz / 64; C = (st & 1) * 32 + (swz % 64) / 2; }
__host__ __device__ __forceinline__ int perm32(int rho) { const int n = rho >> 4, i = rho & 15; return 8 * (i >> 2) + 4 * n + (i & 3); }

struct Unit { int pm, pn; };
struct Gemm { const bf16_t* A; const bf16_t* Bt; int M, N, K; };

struct StaticOrder {
    int nM, nN, nwg, G, c;
    __host__ __device__ void init(int M, int N, int G_, int c_) { nM = M / BM; nN = N / BM; nwg = nM * nN; G = G_; c = c_; }
    __host__ __device__ bool next(int i, Unit& u) const {
        const long L = (long)i * G + c; if (L >= nwg) return false;
        int wgid = (int)L; { const int q = nwg / NXCD, r = nwg % NXCD, xcd = wgid % NXCD, off = wgid / NXCD; wgid = (xcd < r ? xcd * (q + 1) : r * (q + 1) + (xcd - r) * q) + off; }
        const int nig = WGM * nN, gid = wgid / nig, fm = gid * WGM, gsz = (nM - fm) < WGM ? (nM - fm) : WGM;
        u.pm = fm + ((wgid % nig) % gsz); u.pn = (wgid % nig) / gsz; return true;
    }
    __device__ __forceinline__ void a_ready(const Unit&) const {}
    __device__ __forceinline__ void done(const Unit&) const {}
};

__device__ __forceinline__ unsigned cvt_pk_bf16(float lo, float hi) { unsigned r; asm volatile("v_cvt_pk_bf16_f32 %0, %1, %2" : "=v"(r) : "v"(lo), "v"(hi)); return r; }
typedef float f32x2 __attribute__((ext_vector_type(2)));
__device__ __forceinline__ f32x2 gelu_pk(f32x2 v) {
    const f32x2 av = __builtin_elementwise_abs(v), d = av * 0.2316418882f + 1.0f;
    f32x2 t; t.x = __builtin_amdgcn_rcpf(d.x); t.y = __builtin_amdgcn_rcpf(d.y);
    f32x2 q = t * 0.5307027145f + (-0.7265760135f); q = q * t + 0.7107068705f; q = q * t + (-0.142248368f); q = q * t + 0.127414796f; q = q * t;
    const f32x2 s = (v * v) * (-0.72134752044f);
    f32x2 e; e.x = __builtin_amdgcn_exp2f(s.x); e.y = __builtin_amdgcn_exp2f(s.y);
    const f32x2 m = v * (q * e), r = v - m;
    f32x2 o; o.x = v.x < 0.f ? m.x : r.x; o.y = v.y < 0.f ? m.y : r.y; return o;
}

template <int ACT  > struct EpiBf16 {
    static constexpr bool PERM = true, AFTER_DRAIN = false; static_assert(ACT == 0 || ACT == 1, "EpiBf16: ACT is 0 (none) or 1 (gelu_pk)");
    bf16_t* O; int ldc; const float* bias; int split_cols; size_t split_stride; float scale0;
    __device__ __forceinline__ void operator()(const f32x4 (&acc)[2][2][4][2], const Unit& u, int wr, int wc, int fr, int fq) const {
        const int row0 = u.pm * BM + wr * 64 + fr; int colt = u.pn * BM; bf16_t* base = O;
        float sc = 1.f; if (split_cols) { const int t = colt / split_cols; base += (size_t)t * split_stride; colt -= t * split_cols; if (t == 0) sc = scale0; }
        const int col0 = colt + wc * 32 + 8 * fq, bcol0 = u.pn * BM + wc * 32 + 8 * fq;
        f32x4 bv[2][2];
#pragma unroll
        for (int bj = 0; bj < 2; ++bj)
#pragma unroll
            for (int n = 0; n < 2; ++n) bv[bj][n] = bias ? *(const f32x4*)(bias + bcol0 + bj * HALF + 4 * n) : (f32x4){0.f, 0.f, 0.f, 0.f};
#pragma unroll
        for (int ai = 0; ai < 2; ++ai)
#pragma unroll
            for (int m = 0; m < 4; ++m) { bf16_t* rowp = base + (size_t)(row0 + ai * HALF + m * 16) * ldc + col0;
#pragma unroll
                for (int bj = 0; bj < 2; ++bj) { f32x4 v0 = acc[ai][bj][m][0] + bv[bj][0], v1 = acc[ai][bj][m][1] + bv[bj][1];
                    if (ACT == 1) { f32x2 a = gelu_pk((f32x2){v0[0], v0[1]}), b = gelu_pk((f32x2){v0[2], v0[3]}), c = gelu_pk((f32x2){v1[0], v1[1]}), d = gelu_pk((f32x2){v1[2], v1[3]});
                        v0 = (f32x4){a.x, a.y, b.x, b.y}; v1 = (f32x4){c.x, c.y, d.x, d.y}; }
                    v0 = v0 * sc; v1 = v1 * sc; u32x4 w; w.x = cvt_pk_bf16(v0[0], v0[1]); w.y = cvt_pk_bf16(v0[2], v0[3]); w.z = cvt_pk_bf16(v1[0], v1[1]); w.w = cvt_pk_bf16(v1[2], v1[3]);
                    *(u32x4*)(rowp + bj * HALF) = w; } }
    }
};
template <int ACT  > struct EpiStoreBf16 {
    static constexpr bool PERM = true, AFTER_DRAIN = false;
    bf16_t* O; int ldc;
    __device__ __forceinline__ void operator()(const f32x4 (&acc)[2][2][4][2], const Unit& u, int wr, int wc, int fr, int fq) const {
        const int row0 = u.pm * BM + wr * 64 + fr; const int col0 = u.pn * BM + wc * 32 + 8 * fq;
#pragma unroll
        for (int ai = 0; ai < 2; ++ai)
#pragma unroll
            for (int m = 0; m < 4; ++m) { bf16_t* rowp = O + (size_t)(row0 + ai * HALF + m * 16) * ldc + col0;
#pragma unroll
                for (int bj = 0; bj < 2; ++bj) { f32x4 v0 = acc[ai][bj][m][0], v1 = acc[ai][bj][m][1];
                    if (ACT == 1) {
#pragma unroll
                        for (int e = 0; e < 4; ++e) { const float a = fmaxf(v0[e], 0.f), b = fmaxf(v1[e], 0.f); v0[e] = a * a; v1[e] = b * b; } }
                    u32x4 w; w.x = cvt_pk_bf16(v0[0], v0[1]); w.y = cvt_pk_bf16(v0[2], v0[3]); w.z = cvt_pk_bf16(v1[0], v1[1]); w.w = cvt_pk_bf16(v1[2], v1[3]);
                    *(u32x4*)(rowp + bj * HALF) = w; } }
    }
};
struct EpiG1 {
    static constexpr bool PERM = true, AFTER_DRAIN = false;
    bf16_t* H; bf16_t* U;
    __device__ __forceinline__ void operator()(const f32x4 (&acc)[2][2][4][2], const Unit& u, int wr, int wc, int fr, int fq) const {
        const int row0 = u.pm * BM + wr * 64 + fr;
        if (u.pn < 4) {
            const int colu = u.pn * 128 + wc * 32 + 8 * fq;
#pragma unroll
            for (int ai = 0; ai < 2; ++ai)
#pragma unroll
                for (int m = 0; m < 4; ++m) { f32x4 v0 = acc[ai][0][m][0], v1 = acc[ai][0][m][1]; const f32x4 g0 = acc[ai][1][m][0], g1 = acc[ai][1][m][1];
#pragma unroll
                    for (int e = 0; e < 4; ++e) { v0[e] *= __builtin_amdgcn_rcpf(1.0f + __expf(-g0[e])); v1[e] *= __builtin_amdgcn_rcpf(1.0f + __expf(-g1[e])); }
                    u32x4 w; w.x = cvt_pk_bf16(v0[0], v0[1]); w.y = cvt_pk_bf16(v0[2], v0[3]); w.z = cvt_pk_bf16(v1[0], v1[1]); w.w = cvt_pk_bf16(v1[2], v1[3]);
                    *(u32x4*)(U + (size_t)(row0 + ai * HALF + m * 16) * 512 + colu) = w; }
        } else {
            const int col0 = u.pn * BM + wc * 32 + 8 * fq;
#pragma unroll
            for (int ai = 0; ai < 2; ++ai)
#pragma unroll
                for (int m = 0; m < 4; ++m) { bf16_t* rowp = H + (size_t)(row0 + ai * HALF + m * 16) * 3072 + col0;
#pragma unroll
                    for (int bj = 0; bj < 2; ++bj) { const f32x4 v0 = acc[ai][bj][m][0], v1 = acc[ai][bj][m][1];
                        u32x4 w; w.x = cvt_pk_bf16(v0[0], v0[1]); w.y = cvt_pk_bf16(v0[2], v0[3]); w.z = cvt_pk_bf16(v1[0], v1[1]); w.w = cvt_pk_bf16(v1[2], v1[3]);
                        *(u32x4*)(rowp + bj * HALF) = w; } }
        }
    }
};
struct EpiResF32 {
    static constexpr bool PERM = false, AFTER_DRAIN = false;
    const float* base; float* out; int ldc; float alpha;
    __device__ __forceinline__ void operator()(const f32x4 (&acc)[2][2][4][2], const Unit& u, int wr, int wc, int fr, int fq) const {
        const int col0 = u.pn * BM + wc * 32 + 4 * fq;
#pragma unroll
        for (int ai = 0; ai < 2; ++ai)
#pragma unroll
            for (int m = 0; m < 4; ++m) { const size_t off = (size_t)(u.pm * BM + ai * HALF + wr * 64 + m * 16 + fr) * ldc + col0;
#pragma unroll
                for (int bj = 0; bj < 2; ++bj)
#pragma unroll
                    for (int n = 0; n < 2; ++n) { const f32x4 bs = *(const f32x4*)(base + off + bj * HALF + n * 16); const f32x4 o = bs * alpha + acc[ai][bj][m][n];
                        *(f32x4*)(out + off + bj * HALF + n * 16) = o; } }
    }
};
template <class Epi, class Sched, bool ALIGN_EPI = false, bool SP2 = false>
__device__ __forceinline__ void gemm_phase(PG8_LAS unsigned char* lds, const Gemm g, const Sched& S, const Epi& E) {
    const int tid = threadIdx.x, wid = __builtin_amdgcn_readfirstlane(tid >> 6), lane = tid & 63, wr = wid >> 2, wc = wid & 3, fr = lane & 15, fq = lane >> 4;
    const int K = g.K, nt = K / BK;
    unsigned voffA[2], voffB[2];
#pragma unroll
    for (int i = 0; i < 2; ++i) { int R, C; stage_rc(tid * 16 + i * 8192, R, C); const int Rb = Epi::PERM ? ((R & ~31) + perm32(R & 31)) : R;
        voffA[i] = (unsigned)(R * K + C) * 2u; voffB[i] = (unsigned)(Rb * K + C) * 2u; }
    const size_t kstep = (size_t)(BK * 2);
    const size_t hstep = (size_t)HALF * K * 2;
    const size_t tstep = 2 * hstep;
    const unsigned ldsw = (unsigned)wid * 1024u;
    const int aoff = lds_byte(wr * 64 + fr, fq * 8), boff = lds_byte(wc * 32 + fr, fq * 8);
#define PG8_SA(b, h) (((b) * 2 + (h)) * HTB)
#define PG8_SB(b, h) ((4 + (b) * 2 + (h)) * HTB)
#define PG8_STAGE(bufoff, gbase, voff) do { _Pragma("unroll") for (int _i = 0; _i < 2; ++_i) \
        __builtin_amdgcn_global_load_lds((const unsigned*)((const char*)(gbase) + (voff)[_i]), (PG8_LAS unsigned*)(lds + (bufoff) + ldsw + _i * 8192), 16, 0, 0); } while (0)
#define PG8_LDA(dst, b, h) do { _Pragma("unroll") for (int m = 0; m < 4; ++m) _Pragma("unroll") for (int k = 0; k < 2; ++k) dst[m][k] = *(const PG8_LAS bf16x8*)(lds + PG8_SA(b, h) + aoff + m * 2048 + k * 1024); } while (0)
#define PG8_LDB(dst, b, h) do { _Pragma("unroll") for (int n = 0; n < 2; ++n) _Pragma("unroll") for (int k = 0; k < 2; ++k) dst[n][k] = *(const PG8_LAS bf16x8*)(lds + PG8_SB(b, h) + boff + n * 2048 + k * 1024); } while (0)
#define PG8_MMA(ai, bj, At, Bt) do { __builtin_amdgcn_s_setprio(1); _Pragma("unroll") for (int m = 0; m < 4; ++m) _Pragma("unroll") for (int n = 0; n < 2; ++n) _Pragma("unroll") for (int k = 0; k < 2; ++k) \
        acc[ai][bj][m][n] = __builtin_amdgcn_mfma_f32_16x16x32_bf16(Bt[n][k], At[m][k], acc[ai][bj][m][n], 0, 0, 0); __builtin_amdgcn_s_setprio(0); } while (0)
#define PG8_WAIT_V(n) asm volatile("s_waitcnt vmcnt(" #n ")" ::: "memory")
#define PG8_WAIT_L(n) asm volatile("s_waitcnt lgkmcnt(" #n ")" ::: "memory")
#define PG8_BAR __builtin_amdgcn_s_barrier()
#define PG8_SCHED __builtin_amdgcn_sched_barrier(0)
    Unit cur, nxt; int ui = 0;
    if (!S.next(0, cur)) return;
    f32x4 acc[2][2][4][2];
#pragma unroll
    for (int a = 0; a < 2; ++a)
#pragma unroll
        for (int b = 0; b < 2; ++b)
#pragma unroll
            for (int m = 0; m < 4; ++m)
#pragma unroll
                for (int n = 0; n < 2; ++n) acc[a][b][m][n] = (f32x4){0.f, 0.f, 0.f, 0.f};
    bf16x8 At[4][2], B0[2][2], B1[2][2];
    const char* cA = (const char*)g.A + (size_t)cur.pm * tstep; const char* cB = (const char*)g.Bt + (size_t)cur.pn * tstep;
    S.a_ready(cur);
    if constexpr (SP2) {
        PG8_STAGE(PG8_SB(0, 0), cB, voffB); PG8_STAGE(PG8_SB(0, 1), cB + hstep, voffB); PG8_STAGE(PG8_SA(0, 0), cA, voffA); PG8_STAGE(PG8_SA(0, 1), cA + hstep, voffA);
        if (wr == 1) PG8_BAR;
        PG8_WAIT_V(2); PG8_BAR;
        PG8_STAGE(PG8_SB(1, 0), cB + kstep, voffB); PG8_STAGE(PG8_SA(1, 0), cA + kstep, voffA); PG8_STAGE(PG8_SB(1, 1), cB + hstep + kstep, voffB);
        PG8_WAIT_V(6); PG8_BAR;
    } else {
        PG8_STAGE(PG8_SB(0, 0), cB, voffB); PG8_STAGE(PG8_SA(0, 0), cA, voffA); PG8_STAGE(PG8_SB(0, 1), cB + hstep, voffB); PG8_STAGE(PG8_SA(0, 1), cA + hstep, voffA);
        if (wr == 1) PG8_BAR;
        PG8_WAIT_V(4); PG8_BAR;
        PG8_STAGE(PG8_SB(1, 0), cB + kstep, voffB); PG8_STAGE(PG8_SA(1, 0), cA + kstep, voffA); PG8_STAGE(PG8_SB(1, 1), cB + hstep + kstep, voffB);
        PG8_WAIT_V(6); PG8_BAR;
    }
    for (;;) {
        const bool has_next = S.next(ui + 1, nxt);
        const char* nA = has_next ? (const char*)g.A + (size_t)nxt.pm * tstep : cA; const char* nB = has_next ? (const char*)g.Bt + (size_t)nxt.pn * tstep : cB;
        for (int t = 0; t < nt; t += 2) {
            const bool last = (t == nt - 2);
            const char* a1 = cA + (size_t)(t + 1) * kstep;
            const char* a2 = last ? nA : cA + (size_t)(t + 2) * kstep; const char* b2 = last ? nB : cB + (size_t)(t + 2) * kstep;
            const char* a3 = a2 + kstep; const char* b3 = b2 + kstep;
            if (last && has_next) S.a_ready(nxt);
            if constexpr (SP2) {
            PG8_LDB(B0, 0, 0); PG8_LDB(B1, 0, 1); PG8_SCHED; PG8_LDA(At, 0, 0); PG8_STAGE(PG8_SA(1, 1), a1 + hstep, voffA);
            PG8_WAIT_V(8); PG8_WAIT_L(0); PG8_BAR; PG8_MMA(0, 0, At, B0); PG8_MMA(0, 1, At, B1); PG8_BAR; PG8_SCHED;
            PG8_LDA(At, 0, 1); PG8_STAGE(PG8_SB(0, 0), b2, voffB); PG8_STAGE(PG8_SB(0, 1), b2 + hstep, voffB); PG8_STAGE(PG8_SA(0, 0), a2, voffA);
            PG8_WAIT_V(8); PG8_WAIT_L(0); PG8_BAR; PG8_MMA(1, 0, At, B0); PG8_MMA(1, 1, At, B1); PG8_BAR; PG8_SCHED;
            PG8_LDB(B0, 1, 0); PG8_LDB(B1, 1, 1); PG8_SCHED; PG8_LDA(At, 1, 0); PG8_STAGE(PG8_SA(0, 1), a2 + hstep, voffA);
            PG8_WAIT_V(8); PG8_WAIT_L(0); PG8_BAR; PG8_MMA(0, 0, At, B0); PG8_MMA(0, 1, At, B1); PG8_BAR; PG8_SCHED;
            PG8_LDA(At, 1, 1); PG8_STAGE(PG8_SB(1, 0), b3, voffB); PG8_STAGE(PG8_SB(1, 1), b3 + hstep, voffB); PG8_STAGE(PG8_SA(1, 0), a3, voffA);
            PG8_WAIT_V(8); PG8_WAIT_L(0); PG8_BAR; PG8_MMA(1, 0, At, B0); PG8_MMA(1, 1, At, B1); PG8_BAR; PG8_SCHED;
            } else {
            PG8_LDB(B0, 0, 0); PG8_SCHED; PG8_LDA(At, 0, 0); PG8_STAGE(PG8_SA(1, 1), a1 + hstep, voffA);
            PG8_WAIT_L(8); PG8_BAR; PG8_WAIT_L(0); PG8_MMA(0, 0, At, B0); PG8_BAR; PG8_SCHED;
            PG8_LDB(B1, 0, 1); PG8_STAGE(PG8_SB(0, 0), b2, voffB);
            PG8_BAR; PG8_WAIT_L(0); PG8_MMA(0, 1, At, B1); PG8_BAR;
            PG8_LDA(At, 0, 1); PG8_STAGE(PG8_SA(0, 0), a2, voffA);
            PG8_BAR; PG8_WAIT_L(0); PG8_MMA(1, 0, At, B0); PG8_BAR; PG8_SCHED;
            PG8_STAGE(PG8_SB(0, 1), b2 + hstep, voffB);
            PG8_WAIT_V(6); PG8_BAR; PG8_MMA(1, 1, At, B1); PG8_BAR;
            PG8_LDB(B0, 1, 0); PG8_SCHED; PG8_LDA(At, 1, 0); PG8_STAGE(PG8_SA(0, 1), a2 + hstep, voffA);
            PG8_WAIT_L(8); PG8_BAR; PG8_WAIT_L(0); PG8_MMA(0, 0, At, B0); PG8_BAR; PG8_SCHED;
            PG8_LDB(B1, 1, 1); PG8_STAGE(PG8_SB(1, 0), b3, voffB);
            PG8_BAR; PG8_WAIT_L(0); PG8_MMA(0, 1, At, B1); PG8_BAR;
            PG8_LDA(At, 1, 1); PG8_STAGE(PG8_SA(1, 0), a3, voffA);
            PG8_BAR; PG8_WAIT_L(0); PG8_MMA(1, 0, At, B0); PG8_BAR; PG8_SCHED;
            PG8_STAGE(PG8_SB(1, 1), b3 + hstep, voffB);
            PG8_WAIT_V(6); PG8_BAR; PG8_MMA(1, 1, At, B1); PG8_BAR;
            }
        }
        if constexpr (ALIGN_EPI) { if (wr == 0) PG8_BAR; }
        if constexpr (!Epi::AFTER_DRAIN) { E(acc, cur, wr, wc, fr, fq); S.done(cur); }
        if (!has_next) break;
#pragma unroll
        for (int a = 0; a < 2; ++a)
#pragma unroll
            for (int b = 0; b < 2; ++b)
#pragma unroll
                for (int m = 0; m < 4; ++m)
#pragma unroll
                    for (int n = 0; n < 2; ++n) acc[a][b][m][n] = (f32x4){0.f, 0.f, 0.f, 0.f};
        cur = nxt; cA = nA; cB = nB; ++ui;
        if constexpr (ALIGN_EPI) { if (wr == 1) PG8_BAR; }
    }
    PG8_WAIT_V(0);
    if constexpr (!ALIGN_EPI) { if (wr == 0) PG8_BAR; }
    PG8_BAR;
    if constexpr (Epi::AFTER_DRAIN) { E.fused(acc, cur, wr, wc, fr, fq, lds, wid, lane); S.done(cur); }
#undef PG8_SA
#undef PG8_SB
#undef PG8_STAGE
#undef PG8_LDA
#undef PG8_LDB
#undef PG8_MMA
#undef PG8_WAIT_V
#undef PG8_WAIT_L
#undef PG8_BAR
#undef PG8_SCHED
}
}

constexpr int NB = 8, SEQ = 4096, DM = 1024, T = NB * SEQ, NMEM = 256, MEMT = NB * NMEM;
constexpr int CW = 512, CKW = 31, RH = 4, RD = 128, RC = 128, NCH = SEQ / RC, INC = 3072;
constexpr int COL_A = 0, COL_B = 512, COL_Q = 1024, COL_K = 1536, COL_V = 2048, COL_G = 2560;
constexpr int XH = 4, XD = 256, FF = 4096;
constexpr float LN_EPS = 1e-5f;
constexpr float DN_ALPHA = 1.189207115002721f;
constexpr int NPHASE = 14;

constexpr size_t MiB = 1u << 20;
constexpr size_t WS_ROPE = 2 * MiB;
constexpr size_t WS_WIN = 8 * MiB, WS_WOUT = 14 * MiB, WS_WXQ = 16 * MiB, WS_WXK = 18 * MiB, WS_WXV = 20 * MiB, WS_WXO = 22 * MiB, WS_WUP = 24 * MiB, WS_WDN = 32 * MiB;
constexpr size_t WS_MEMB = 40 * MiB, WS_KM = 44 * MiB, WS_VT = 48 * MiB;
constexpr size_t WS_XB = 64 * MiB;
constexpr size_t WS_CAT = 128 * MiB;
constexpr size_t WS_H = 192 * MiB;
constexpr size_t WS_KV = 384 * MiB;
constexpr size_t WS_SBF = 448 * MiB;
constexpr size_t WS_HID = 192 * MiB;
constexpr size_t WS_U = 480 * MiB;
constexpr size_t WS_END = 512 * MiB;

constexpr int LDS_BYTES = 147456;
constexpr int NWAVES = 8;

#define GAS __attribute__((address_space(1)))
#define LAS __attribute__((address_space(3)))
typedef unsigned short bf16;
typedef unsigned v4u __attribute__((ext_vector_type(4)));
typedef unsigned v2u __attribute__((ext_vector_type(2)));
typedef float f32x4 __attribute__((ext_vector_type(4)));
typedef short bf16x8 __attribute__((ext_vector_type(8)));
typedef short s16x4 __attribute__((ext_vector_type(4)));
#define LDS_WAIT() asm volatile("s_waitcnt lgkmcnt(0)" ::: "memory")

__device__ __forceinline__ unsigned f2bf(float f) { unsigned u = __builtin_bit_cast(unsigned, f); return (u + 0x7fffu + ((u >> 16) & 1u)) >> 16; }
__device__ __forceinline__ unsigned pk2(float lo, float hi) { return f2bf(lo) | (f2bf(hi) << 16); }
__device__ __forceinline__ float bflo(unsigned w) { return __builtin_bit_cast(float, w << 16); }
__device__ __forceinline__ float bfhi(unsigned w) { return __builtin_bit_cast(float, w & 0xffff0000u); }
__device__ __forceinline__ float bf1(bf16 b) { return __builtin_bit_cast(float, (unsigned)b << 16); }
__device__ __forceinline__ float wave_sum(float v) {
#pragma unroll
    for (int o = 1; o < 64; o <<= 1) v += __shfl_xor(v, o);
    return v;
}
__device__ __forceinline__ float sigmoidf_(float v) { return 1.0f / (1.0f + __expf(-v)); }

static __device__ const float ROPE_INV[64] = {
1.000000000e+00f, 8.639884591e-01f, 7.464760542e-01f, 6.449466348e-01f, 5.572264791e-01f, 4.814372361e-01f, 4.159561992e-01f, 3.593813479e-01f, 3.105013072e-01f, 2.682695389e-01f, 2.317818105e-01f, 2.002568096e-01f, 1.730195731e-01f, 1.494868994e-01f, 1.291549653e-01f, 1.115883961e-01f, 9.641107172e-02f, 8.329805732e-02f, 7.196855545e-02f, 6.218000501e-02f, 5.372280627e-02f, 4.641588405e-02f, 4.010278732e-02f, 3.464834765e-02f, 2.993577160e-02f, 2.586415969e-02f, 2.234633639e-02f, 1.930697635e-02f, 1.668100432e-02f, 1.441219542e-02f, 1.245197095e-02f, 1.075835899e-02f, 9.295094758e-03f, 8.030855097e-03f, 6.938565988e-03f, 5.994841456e-03f, 5.179473665e-03f, 4.475004971e-03f, 3.866352839e-03f, 3.340484342e-03f, 2.886140021e-03f, 2.493591513e-03f, 2.154434333e-03f, 1.861406374e-03f, 1.608233550e-03f, 1.389495214e-03f, 1.200507861e-03f, 1.037224894e-03f, 8.961503627e-04f, 7.742635789e-04f, 6.689548027e-04f, 5.779691855e-04f, 4.993587499e-04f, 4.314401885e-04f, 3.727593576e-04f, 3.220597864e-04f, 2.782559022e-04f, 2.404099068e-04f, 2.077113895e-04f, 1.794602285e-04f, 1.550515735e-04f, 1.339627779e-04f, 1.157422885e-04f, 9.999999747e-05f };

struct Args {
    const float* in[22]; float* out; unsigned char* ws; int ph_lo, ph_hi;
};

template <bool GLU = false>
__device__ __forceinline__ void p0_transpose_item(const float* W, int K, int N, bf16* WT, LAS float* scr, int item, int lane) {
    const int nblk = N / 32, kb = item / nblk, nb = item % nblk, k0 = 64 * kb, n0 = 32 * nb;
    const int r0 = !GLU ? n0 : (n0 < 512) ? (n0 >> 7) * 256 + (n0 & 127) : (n0 < 1024) ? ((n0 - 512) >> 7) * 256 + 128 + (n0 & 127) : n0;
#pragma unroll 8
    for (int i = 0; i < 32; ++i) { const int kk = 2 * i + (lane >> 5); scr[kk * 33 + (lane & 31)] = W[(size_t)(k0 + kk) * N + n0 + (lane & 31)]; }
    LDS_WAIT(); asm volatile("" ::: "memory");
    const int c = lane & 7;
#pragma unroll
    for (int j = 0; j < 4; ++j) { const int n = (lane >> 3) + 8 * j; const LAS float* s = scr + (8 * c) * 33 + n;
        v4u o; o.x = pk2(s[0 * 33], s[1 * 33]); o.y = pk2(s[2 * 33], s[3 * 33]); o.z = pk2(s[4 * 33], s[5 * 33]); o.w = pk2(s[6 * 33], s[7 * 33]);
        *(v4u*)(WT + (size_t)(r0 + n) * K + k0 + 8 * c) = o; }
    LDS_WAIT(); asm volatile("" ::: "memory");
}
__device__ __forceinline__ void cvt_rows(const float* src, bf16* dst, int n8, int gt, int NT) {
    for (int i = gt; i < n8; i += NT) {
        const f32x4 a = *(const f32x4*)(src + (size_t)i * 8), b = *(const f32x4*)(src + (size_t)i * 8 + 4);
        v4u o; o.x = pk2(a.x, a.y); o.y = pk2(a.z, a.w); o.z = pk2(b.x, b.y); o.w = pk2(b.z, b.w);
        *(v4u*)(dst + (size_t)i * 8) = o; }
}
__device__ __forceinline__ void p0_prologue(const Args& A, LAS unsigned char* lds, int vcu, int G, int tid, int wave, int lane) {
    unsigned char* ws = A.ws;
    LAS float* scr = (LAS float*)(lds + wave * 16384);
    const int gw = vcu * NWAVES + wave, NGW = G * NWAVES;
    constexpr int I_IN = 16 * 96, I_SQ = 16 * 32, I_UP = 16 * 128, I_DN = 64 * 32;
    constexpr int NITEMS = I_IN + 5 * I_SQ + I_UP + I_DN;
    for (int it = gw; it < NITEMS; it += NGW) {
        int r = it;
        if (r < I_IN) { p0_transpose_item<true>(A.in[2], 1024, 3072, (bf16*)(ws + WS_WIN), scr, r, lane); continue; } r -= I_IN;
        if (r < I_SQ) { p0_transpose_item(A.in[9], 1024, 1024, (bf16*)(ws + WS_WOUT), scr, r, lane); continue; } r -= I_SQ;
        if (r < I_SQ) { p0_transpose_item(A.in[12], 1024, 1024, (bf16*)(ws + WS_WXQ), scr, r, lane); continue; } r -= I_SQ;
        if (r < I_SQ) { p0_transpose_item(A.in[13], 1024, 1024, (bf16*)(ws + WS_WXK), scr, r, lane); continue; } r -= I_SQ;
        if (r < I_SQ) { p0_transpose_item(A.in[14], 1024, 1024, (bf16*)(ws + WS_WXV), scr, r, lane); continue; } r -= I_SQ;
        if (r < I_SQ) { p0_transpose_item(A.in[15], 1024, 1024, (bf16*)(ws + WS_WXO), scr, r, lane); continue; } r -= I_SQ;
        if (r < I_UP) { p0_transpose_item(A.in[18], 1024, 4096, (bf16*)(ws + WS_WUP), scr, r, lane); continue; } r -= I_UP;
        p0_transpose_item(A.in[19], 4096, 1024, (bf16*)(ws + WS_WDN), scr, r, lane);
    }
    const int gt = vcu * 512 + tid, NT = G * 512;
    cvt_rows(A.in[0], (bf16*)(ws + WS_XB), T * DM / 8, gt, NT);
    cvt_rows(A.in[1], (bf16*)(ws + WS_MEMB), MEMT * DM / 8, gt, NT);
    float* cosT = (float*)(ws + WS_ROPE); float* sinT = cosT + SEQ * 64;
    for (int i = gt; i < SEQ * 64; i += NT) {
        const int pos = i >> 6, j = i & 63;
        const float ang = (float)pos * ROPE_INV[j];
        const double a = (double)ang; const double kq = rint(a * 0.63661977236758134308);
        const double r = a - kq * 1.57079632679489661923; const double r2 = r * r;
        double s = -2.5052108385441718775e-08; s = s * r2 + 2.7557319223985890653e-06; s = s * r2 - 1.9841269841269841270e-04; s = s * r2 + 8.3333333333333333333e-03; s = s * r2 - 1.6666666666666666667e-01; s = s * r2 * r + r;
        double c = 2.0876756987868098979e-09; c = c * r2 - 2.7557319223985890653e-07; c = c * r2 + 2.4801587301587301587e-05; c = c * r2 - 1.3888888888888888889e-03; c = c * r2 + 4.1666666666666666667e-02; c = c * r2 - 0.5; c = c * r2 + 1.0;
        const int q = ((int)kq) & 3;
        const double sv = (q == 0) ? s : (q == 1) ? c : (q == 2) ? -s : -c;
        const double cv = (q == 0) ? c : (q == 1) ? -s : (q == 2) ? -c : s;
        cosT[i] = (float)cv; sinT[i] = (float)sv;
    }
}

__device__ __forceinline__ void ln_phase(float* io, const float* g, const float* b, bf16* ob, int vcu, int G, int wave, int lane) {
    const int gw = vcu * NWAVES + wave, NGW = G * NWAVES;
    f32x4 gv[4], bv[4];
#pragma unroll
    for (int j = 0; j < 4; ++j) { gv[j] = *(const f32x4*)(g + 4 * (lane + 64 * j)); bv[j] = *(const f32x4*)(b + 4 * (lane + 64 * j)); }
    for (int m = gw; m < T; m += NGW) {
        f32x4* xr = (f32x4*)(io + (size_t)m * DM) + lane;
        f32x4 v[4]; float s = 0.f;
#pragma unroll
        for (int j = 0; j < 4; ++j) { v[j] = xr[64 * j]; s += (v[j].x + v[j].y) + (v[j].z + v[j].w); }
        const float mean = wave_sum(s) * (1.f / DM); float s2 = 0.f;
#pragma unroll
        for (int j = 0; j < 4; ++j) { v[j] = v[j] - mean; s2 += (v[j].x * v[j].x + v[j].y * v[j].y) + (v[j].z * v[j].z + v[j].w * v[j].w); }
        const float rstd = 1.f / sqrtf(wave_sum(s2) * (1.f / DM) + LN_EPS);
#pragma unroll
        for (int j = 0; j < 4; ++j) { v[j] = v[j] * rstd * gv[j] + bv[j]; xr[64 * j] = v[j]; }
        if (ob) { unsigned long long* o8 = (unsigned long long*)(ob + (size_t)m * DM) + lane;
#pragma unroll
            for (int j = 0; j < 4; ++j) o8[64 * j] = (unsigned long long)pk2(v[j].x, v[j].y) | ((unsigned long long)pk2(v[j].z, v[j].w) << 32); }
    }
}

__device__ __forceinline__ void conv_phase(const Args& A, LAS unsigned char* lds, int vcu, int G, int tid, int wave, int lane) {
    const bf16* U = (const bf16*)(A.ws + WS_U); bf16* cat = (bf16*)(A.ws + WS_CAT);
    const float* conv_w = A.in[3]; const int c = tid;
    float w[CKW];
#pragma unroll
    for (int j = 0; j < CKW; ++j) w[j] = conv_w[j * CW + c];
    const float bias = A.in[4][c];
    LAS bf16* ubuf = (LAS bf16*)lds;
    LAS float* ybuf = (LAS float*)(lds + 63488);
    const f32x4 g0 = *(const f32x4*)(A.in[5] + 8 * lane), g1 = *(const f32x4*)(A.in[5] + 8 * lane + 4);
    const f32x4 b0 = *(const f32x4*)(A.in[6] + 8 * lane), b1 = *(const f32x4*)(A.in[6] + 8 * lane + 4);
    constexpr int NU = NB * (SEQ / 32);
    v4u pre[8];
#define CONV_PREFETCH(unit_) do { const int b_ = (unit_) / (SEQ / 32), t0_ = ((unit_) % (SEQ / 32)) * 32; \
        _Pragma("unroll") for (int k = 0; k < 8; ++k) { const int p = tid + 512 * k; const int row = p >> 6, ch = p & 63; const int t = t0_ - 30 + row; \
            if (p < 62 * 64 && t >= 0) pre[k] = *(const v4u*)(U + ((size_t)b_ * SEQ + t) * CW + 8 * ch); else pre[k] = (v4u){0u, 0u, 0u, 0u}; } } while (0)
    int unit = vcu;
    if (unit < NU) CONV_PREFETCH(unit);
    for (; unit < NU; unit += G) {
        const int b = unit / (SEQ / 32), t0 = (unit % (SEQ / 32)) * 32;
#pragma unroll
        for (int k = 0; k < 8; ++k) { const int p = tid + 512 * k; if (p < 62 * 64) *(LAS v4u*)(ubuf + 8 * p) = pre[k]; }
        __syncthreads();
        float u[62];
#pragma unroll
        for (int i = 0; i < 62; ++i) u[i] = bf1(ubuf[i * CW + c]);
        if (unit + G < NU) CONV_PREFETCH(unit + G);
#pragma unroll
        for (int tt = 0; tt < 32; ++tt) { float y = bias;
#pragma unroll
            for (int j = 0; j < CKW; ++j) y += w[j] * u[tt + j];
            ybuf[tt * CW + c] = y; }
        __syncthreads();
#pragma unroll
        for (int k = 0; k < 4; ++k) { const int tt = 4 * wave + k;
            const LAS f32x4* yr = (const LAS f32x4*)(ybuf + tt * CW) + 2 * lane;
            f32x4 v0 = yr[0], v1 = yr[1];
            const float mean = wave_sum((v0.x + v0.y) + (v0.z + v0.w) + (v1.x + v1.y) + (v1.z + v1.w)) * (1.f / CW);
            v0 = v0 - mean; v1 = v1 - mean;
            const float var = wave_sum((v0.x * v0.x + v0.y * v0.y) + (v0.z * v0.z + v0.w * v0.w) + (v1.x * v1.x + v1.y * v1.y) + (v1.z * v1.z + v1.w * v1.w)) * (1.f / CW);
            const float rstd = 1.f / sqrtf(var + LN_EPS);
            v0 = v0 * rstd * g0 + b0; v1 = v1 * rstd * g1 + b1;
#pragma unroll
            for (int e = 0; e < 4; ++e) { v0[e] = v0[e] * sigmoidf_(v0[e]); v1[e] = v1[e] * sigmoidf_(v1[e]); }
            v4u o; o.x = pk2(v0.x, v0.y); o.y = pk2(v0.z, v0.w); o.z = pk2(v1.x, v1.y); o.w = pk2(v1.z, v1.w);
            *(v4u*)(cat + ((size_t)b * SEQ + t0 + tt) * DM + 8 * lane) = o; }
    }
#undef CONV_PREFETCH
    __syncthreads();
}

constexpr int RP = 136;
template <bool TRANSPOSED, bool KDEC>
__device__ __forceinline__ void stage_rot(const bf16* h, size_t row0, int col0, int pos0, const float* cosT, const float* sinT, float sc, float lg2, LAS bf16* dst, int tid) {
#pragma unroll
    for (int k = 0; k < 2; ++k) {
        const int item = tid + 512 * k; const int m = item & 127, i = item >> 7;
        const bf16* hp = h + (row0 + m) * INC + col0 + 8 * i;
        const v4u k1 = *(const v4u*)hp, k2 = *(const v4u*)(hp + 64);
        const float* cp = cosT + (size_t)(pos0 + m) * 64 + 8 * i; const float* sp = sinT + (size_t)(pos0 + m) * 64 + 8 * i;
        const f32x4 c0 = *(const f32x4*)cp, c1 = *(const f32x4*)(cp + 4), s0 = *(const f32x4*)sp, s1 = *(const f32x4*)(sp + 4);
        float a[8], bq[8], cs[8], sn[8];
        a[0] = bflo(k1.x); a[1] = bfhi(k1.x); a[2] = bflo(k1.y); a[3] = bfhi(k1.y); a[4] = bflo(k1.z); a[5] = bfhi(k1.z); a[6] = bflo(k1.w); a[7] = bfhi(k1.w);
        bq[0] = bflo(k2.x); bq[1] = bfhi(k2.x); bq[2] = bflo(k2.y); bq[3] = bfhi(k2.y); bq[4] = bflo(k2.z); bq[5] = bfhi(k2.z); bq[6] = bflo(k2.w); bq[7] = bfhi(k2.w);
        cs[0] = c0.x; cs[1] = c0.y; cs[2] = c0.z; cs[3] = c0.w; cs[4] = c1.x; cs[5] = c1.y; cs[6] = c1.z; cs[7] = c1.w;
        sn[0] = s0.x; sn[1] = s0.y; sn[2] = s0.z; sn[3] = s0.w; sn[4] = s1.x; sn[5] = s1.y; sn[6] = s1.z; sn[7] = s1.w;
        float scl = sc; if (KDEC) scl *= exp2f(lg2 * (float)(127 - m));
        float o1[8], o2[8];
#pragma unroll
        for (int j = 0; j < 8; ++j) { o1[j] = (a[j] * cs[j] - bq[j] * sn[j]) * scl; o2[j] = (bq[j] * cs[j] + a[j] * sn[j]) * scl; }
        if (TRANSPOSED) {
#pragma unroll
            for (int j = 0; j < 8; ++j) { dst[(8 * i + j) * RP + m] = (bf16)f2bf(o1[j]); dst[(64 + 8 * i + j) * RP + m] = (bf16)f2bf(o2[j]); }
        } else {
            v4u w1, w2; w1.x = pk2(o1[0], o1[1]); w1.y = pk2(o1[2], o1[3]); w1.z = pk2(o1[4], o1[5]); w1.w = pk2(o1[6], o1[7]);
            w2.x = pk2(o2[0], o2[1]); w2.y = pk2(o2[2], o2[3]); w2.z = pk2(o2[4], o2[5]); w2.w = pk2(o2[6], o2[7]);
            *(LAS v4u*)(dst + m * RP + 8 * i) = w1; *(LAS v4u*)(dst + m * RP + 64 + 8 * i) = w2;
        }
    }
}
__device__ __forceinline__ void stage_vT(const bf16* h, size_t row0, int col0, LAS bf16* dst, int tid) {
#pragma unroll
    for (int k = 0; k < 4; ++k) {
        const int item = tid + 512 * k; const int m = item & 127, i = item >> 7;
        const v4u v = *(const v4u*)(h + (row0 + m) * INC + col0 + 8 * i);
        LAS bf16* d = dst + (8 * i) * RP + m;
        d[0 * RP] = (bf16)(v.x & 0xffffu); d[1 * RP] = (bf16)(v.x >> 16); d[2 * RP] = (bf16)(v.y & 0xffffu); d[3 * RP] = (bf16)(v.y >> 16);
        d[4 * RP] = (bf16)(v.z & 0xffffu); d[5 * RP] = (bf16)(v.z >> 16); d[6 * RP] = (bf16)(v.w & 0xffffu); d[7 * RP] = (bf16)(v.w >> 16);
    }
}
__device__ __forceinline__ float head_lg2(int hd) { return log2f(1.0f - exp2f(-5.0f - (float)hd)); }

__device__ __forceinline__ void ret_kv_phase(const Args& A, LAS unsigned char* lds, int vcu, int G, int tid, int wave, int lane) {
    const bf16* h = (const bf16*)(A.ws + WS_H); float* KV = (float*)(A.ws + WS_KV);
    const float* cosT = (const float*)(A.ws + WS_ROPE); const float* sinT = cosT + SEQ * 64;
    LAS bf16* KT = (LAS bf16*)lds; LAS bf16* VT = KT + 128 * RP;
    const int fr = lane & 15, fq = lane >> 4;
    for (int unit = vcu; unit < NB * RH * NCH; unit += G) {
        const int c = unit % NCH, hd = (unit / NCH) % RH, b = unit / (NCH * RH);
        const size_t row0 = (size_t)b * SEQ + c * RC;
        stage_rot<true, true>(h, row0, COL_K + hd * RD, c * RC, cosT, sinT, 1.0f, head_lg2(hd), KT, tid);
        stage_vT(h, row0, COL_V + hd * RD, VT, tid);
        __syncthreads();
        bf16x8 af[4];
#pragma unroll
        for (int km = 0; km < 4; ++km) af[km] = *(const LAS bf16x8*)(KT + (16 * wave + fr) * RP + 8 * fq + 32 * km);
        float* outp = KV + (size_t)unit * (RD * RD);
#pragma unroll
        for (int et = 0; et < 8; ++et) { f32x4 acc = {0.f, 0.f, 0.f, 0.f};
#pragma unroll
            for (int km = 0; km < 4; ++km) { const bf16x8 bfr = *(const LAS bf16x8*)(VT + (16 * et + fr) * RP + 8 * fq + 32 * km);
                acc = __builtin_amdgcn_mfma_f32_16x16x32_bf16(af[km], bfr, acc, 0, 0, 0); }
            *(f32x4*)(outp + (16 * et + fr) * RD + 16 * wave + 4 * fq) = acc; }
        __syncthreads();
    }
}
__device__ __forceinline__ void ret_scan_phase(const Args& A, int vcu, int G, int tid) {
    const float* KV = (const float*)(A.ws + WS_KV); bf16* SB = (bf16*)(A.ws + WS_SBF);
    const int gt = vcu * 512 + tid, NT = G * 512;
    for (int idx = gt; idx < NB * RH * (RD * RD / 4); idx += NT) {
        const int bh = idx >> 12, e4 = idx & 4095, hd = bh & 3;
        const float gC = exp2f(head_lg2(hd) * 128.0f);
        f32x4 st = {0.f, 0.f, 0.f, 0.f};
        const float* kp = KV + (size_t)bh * NCH * (RD * RD) + 4 * e4; bf16* sp = SB + (size_t)bh * NCH * (RD * RD) + 4 * e4;
#pragma unroll 8
        for (int c = 0; c < NCH; ++c) {
            v2u o; o.x = pk2(st.x, st.y); o.y = pk2(st.z, st.w); *(v2u*)(sp + (size_t)c * (RD * RD)) = o;
            const f32x4 kv = *(const f32x4*)(kp + (size_t)c * (RD * RD)); st = st * gC + kv; }
    }
}
__device__ __forceinline__ void ret_out_phase(const Args& A, LAS unsigned char* lds, int vcu, int G, int tid, int wave, int lane) {
    const bf16* h = (const bf16*)(A.ws + WS_H); const bf16* SB = (const bf16*)(A.ws + WS_SBF); bf16* cat = (bf16*)(A.ws + WS_CAT);
    const float* cosT = (const float*)(A.ws + WS_ROPE); const float* sinT = cosT + SEQ * 64;
    const float* gng = A.in[7]; const float* gnb = A.in[8];
    LAS bf16* Qs = (LAS bf16*)lds; LAS bf16* Ks = Qs + 128 * RP; LAS bf16* VT = Ks + 128 * RP; LAS bf16* ST = VT + 128 * RP;
    const int fr = lane & 15, fq = lane >> 4;
    for (int unit = vcu; unit < NB * RH * NCH; unit += G) {
        const int c = unit % NCH, hd = (unit / NCH) % RH, b = unit / (NCH * RH);
        const size_t row0 = (size_t)b * SEQ + c * RC; const float lg2 = head_lg2(hd);
        stage_rot<false, false>(h, row0, COL_Q + hd * RD, c * RC, cosT, sinT, 0.08838834764831845f, 0.f, Qs, tid);
        stage_rot<false, false>(h, row0, COL_K + hd * RD, c * RC, cosT, sinT, 1.0f, 0.f, Ks, tid);
        stage_vT(h, row0, COL_V + hd * RD, VT, tid);
        { const bf16* sp = SB + (size_t)unit * (RD * RD);
#pragma unroll
          for (int k = 0; k < 4; ++k) { const int item = tid + 512 * k; const int e = item >> 4, i = item & 15;
              *(LAS v4u*)(ST + e * RP + 8 * i) = *(const v4u*)(sp + e * RD + 8 * i); } }
        __syncthreads();
        bf16x8 qf[4];
#pragma unroll
        for (int kd = 0; kd < 4; ++kd) qf[kd] = *(const LAS bf16x8*)(Qs + (16 * wave + fr) * RP + 8 * fq + 32 * kd);
        v2u pk[8];
        const int n = 16 * wave + fr;
#pragma unroll
        for (int mt = 0; mt < 8; ++mt) {
            if (mt <= wave) {
                f32x4 s = {0.f, 0.f, 0.f, 0.f};
#pragma unroll
                for (int kd = 0; kd < 4; ++kd) { const bf16x8 kf = *(const LAS bf16x8*)(Ks + (16 * mt + fr) * RP + 8 * fq + 32 * kd);
                    s = __builtin_amdgcn_mfma_f32_16x16x32_bf16(kf, qf[kd], s, 0, 0, 0); }
                float p[4];
#pragma unroll
                for (int r = 0; r < 4; ++r) { const int m = 16 * mt + 4 * fq + r; const int rel = n - m; p[r] = (rel >= 0) ? s[r] * exp2f(lg2 * (float)rel) : 0.f; }
                pk[mt].x = pk2(p[0], p[1]); pk[mt].y = pk2(p[2], p[3]);
            } else { pk[mt].x = 0u; pk[mt].y = 0u; }
        }
        f32x4 yi[8], yc[8];
#pragma unroll
        for (int et = 0; et < 8; ++et) { yi[et] = (f32x4){0.f, 0.f, 0.f, 0.f}; yc[et] = (f32x4){0.f, 0.f, 0.f, 0.f}; }
#pragma unroll
        for (int kt = 0; kt < 4; ++kt) {
            if (2 * kt <= wave) {
                bf16x8 pf = __builtin_bit_cast(bf16x8, (v4u){pk[2 * kt].x, pk[2 * kt].y, pk[2 * kt + 1].x, pk[2 * kt + 1].y});
#pragma unroll
                for (int et = 0; et < 8; ++et) {
                    const LAS bf16* vp = VT + (16 * et + fr) * RP + 32 * kt + 4 * fq;
                    const v2u v0 = *(const LAS v2u*)vp, v1 = *(const LAS v2u*)(vp + 16);
                    const bf16x8 vf = __builtin_bit_cast(bf16x8, (v4u){v0.x, v0.y, v1.x, v1.y});
                    yi[et] = __builtin_amdgcn_mfma_f32_16x16x32_bf16(vf, pf, yi[et], 0, 0, 0); }
            }
        }
#pragma unroll
        for (int kd = 0; kd < 4; ++kd)
#pragma unroll
            for (int et = 0; et < 8; ++et) { const bf16x8 sf = *(const LAS bf16x8*)(ST + (16 * et + fr) * RP + 8 * fq + 32 * kd);
                yc[et] = __builtin_amdgcn_mfma_f32_16x16x32_bf16(sf, qf[kd], yc[et], 0, 0, 0); }
        const float qdec = exp2f(lg2 * (float)(n + 1));
        float s1 = 0.f;
#pragma unroll
        for (int et = 0; et < 8; ++et) { yi[et] = yi[et] + yc[et] * qdec; s1 += (yi[et].x + yi[et].y) + (yi[et].z + yi[et].w); }
        s1 += __shfl_xor(s1, 16); s1 += __shfl_xor(s1, 32);
        const float mean = s1 * (1.f / RD); float s2 = 0.f;
#pragma unroll
        for (int et = 0; et < 8; ++et) { yi[et] = yi[et] - mean; s2 += (yi[et].x * yi[et].x + yi[et].y * yi[et].y) + (yi[et].z * yi[et].z + yi[et].w * yi[et].w); }
        s2 += __shfl_xor(s2, 16); s2 += __shfl_xor(s2, 32);
        const float rstd = 1.f / sqrtf(s2 * (1.f / RD) + LN_EPS);
        const size_t row = row0 + n;
#pragma unroll
        for (int et = 0; et < 8; ++et) { const int e = 16 * et + 4 * fq;
            const f32x4 gg = *(const f32x4*)(gng + hd * RD + e), gb = *(const f32x4*)(gnb + hd * RD + e);
            const v2u gw = *(const v2u*)(h + row * INC + COL_G + hd * RD + e);
            const float g0 = bflo(gw.x), g1 = bfhi(gw.x), g2 = bflo(gw.y), g3 = bfhi(gw.y);
            f32x4 o = yi[et] * rstd * gg + gb;
            o.x *= g0 * sigmoidf_(g0); o.y *= g1 * sigmoidf_(g1); o.z *= g2 * sigmoidf_(g2); o.w *= g3 * sigmoidf_(g3);
            v2u w; w.x = pk2(o.x, o.y); w.y = pk2(o.z, o.w);
            *(v2u*)(cat + row * DM + CW + hd * RD + e) = w; }
        __syncthreads();
    }
}

constexpr int XP = 264;
__device__ __forceinline__ void xattn_phase(const Args& A, LAS unsigned char* lds, int vcu, int G, int tid, int wave, int lane) {
    const bf16* QO = (const bf16*)(A.ws + WS_CAT); bf16* OB = (bf16*)(A.ws + WS_XB); const bf16* KM = (const bf16*)(A.ws + WS_KM); const bf16* VTm = (const bf16*)(A.ws + WS_VT);
    LAS bf16* L = (LAS bf16*)lds;
    const int fr = lane & 15, fq = lane >> 4;
    constexpr float SC = 0.0625f * 1.4426950408889634f;
    for (int unit = vcu; unit < NB * XH * (SEQ / 128); unit += G) {
        const int qb = unit % (SEQ / 128), hd = (unit / (SEQ / 128)) % XH, b = unit / ((SEQ / 128) * XH);
#pragma unroll
        for (int k = 0; k < 16; ++k) { const int item = tid + 512 * k; const int m = item >> 5, i = item & 31;
            *(LAS v4u*)(L + m * XP + 8 * i) = *(const v4u*)(KM + ((size_t)b * NMEM + m) * DM + hd * XD + 8 * i); }
        const size_t row = (size_t)b * SEQ + qb * 128 + 16 * wave + fr;
        bf16x8 qf[8];
#pragma unroll
        for (int kd = 0; kd < 8; ++kd) qf[kd] = *(const bf16x8*)(QO + row * DM + hd * XD + 8 * fq + 32 * kd);
        __syncthreads();
        f32x4 s[16];
#pragma unroll
        for (int mt = 0; mt < 16; ++mt) { s[mt] = (f32x4){0.f, 0.f, 0.f, 0.f};
#pragma unroll
            for (int kd = 0; kd < 8; ++kd) { const bf16x8 kf = *(const LAS bf16x8*)(L + (16 * mt + fr) * XP + 8 * fq + 32 * kd);
                s[mt] = __builtin_amdgcn_mfma_f32_16x16x32_bf16(kf, qf[kd], s[mt], 0, 0, 0); } }
        float mx = -3.0e38f;
#pragma unroll
        for (int mt = 0; mt < 16; ++mt) mx = fmaxf(mx, fmaxf(fmaxf(s[mt].x, s[mt].y), fmaxf(s[mt].z, s[mt].w)));
        mx = fmaxf(mx, __shfl_xor(mx, 16)); mx = fmaxf(mx, __shfl_xor(mx, 32));
        float sum = 0.f; v2u pk[16];
#pragma unroll
        for (int mt = 0; mt < 16; ++mt) { f32x4 p;
#pragma unroll
            for (int r = 0; r < 4; ++r) p[r] = exp2f((s[mt][r] - mx) * SC);
            sum += (p.x + p.y) + (p.z + p.w); pk[mt].x = pk2(p.x, p.y); pk[mt].y = pk2(p.z, p.w); }
        sum += __shfl_xor(sum, 16); sum += __shfl_xor(sum, 32);
        const float inv = 1.0f / sum;
        __syncthreads();
#pragma unroll
        for (int k = 0; k < 16; ++k) { const int item = tid + 512 * k; const int d = item >> 5, i = item & 31;
            *(LAS v4u*)(L + d * XP + 8 * i) = *(const v4u*)(VTm + ((size_t)hd * XD + d) * MEMT + b * NMEM + 8 * i); }
        __syncthreads();
        f32x4 o[16];
#pragma unroll
        for (int dt = 0; dt < 16; ++dt) o[dt] = (f32x4){0.f, 0.f, 0.f, 0.f};
#pragma unroll
        for (int kt = 0; kt < 8; ++kt) {
            const bf16x8 pf = __builtin_bit_cast(bf16x8, (v4u){pk[2 * kt].x, pk[2 * kt].y, pk[2 * kt + 1].x, pk[2 * kt + 1].y});
#pragma unroll
            for (int dt = 0; dt < 16; ++dt) { const LAS bf16* vp = L + (16 * dt + fr) * XP + 32 * kt + 4 * fq;
                const v2u v0 = *(const LAS v2u*)vp, v1 = *(const LAS v2u*)(vp + 16);
                const bf16x8 vf = __builtin_bit_cast(bf16x8, (v4u){v0.x, v0.y, v1.x, v1.y});
                o[dt] = __builtin_amdgcn_mfma_f32_16x16x32_bf16(vf, pf, o[dt], 0, 0, 0); } }
#pragma unroll
        for (int dt = 0; dt < 16; ++dt) { const f32x4 v = o[dt] * inv; v2u w; w.x = pk2(v.x, v.y); w.y = pk2(v.z, v.w);
            *(v2u*)(OB + row * DM + hd * XD + 16 * dt + 4 * fq) = w; }
        __syncthreads();
    }
}

#define XB_TMO      128
#define XB_XCNT(j)  (256  + 64 * (j))
#define XB_XSUB(j)  (1280 + 64 * (j))
#define XB_XGEN(j)  (2304 + 64 * (j))
#define XB_TOP      3328
#define XB_TOPGEN   3392
#define XCD_BAR_WORDS 3456
#define XB_SPIN_CAP (1u << 18)

__device__ __forceinline__ unsigned xb_ld(unsigned* p)              { return __hip_atomic_load(p, __ATOMIC_RELAXED, __HIP_MEMORY_SCOPE_AGENT); }
__device__ __forceinline__ unsigned xb_add(unsigned* p, unsigned v) { return __hip_atomic_fetch_add(p, v, __ATOMIC_RELAXED, __HIP_MEMORY_SCOPE_AGENT); }
__device__ __forceinline__ unsigned xb_xcc_id() { return (unsigned)__builtin_amdgcn_s_getreg((3 << 11) | 20) & 0xFu; }
#define XB_SPIN(cond, bar) do { unsigned _sp = 0; while (cond) { __builtin_amdgcn_s_sleep(1); \
    if ((++_sp & 255u) == 0u) { if (xb_ld(&(bar)[XB_TMO])) break; if (_sp > XB_SPIN_CAP) { atomicAdd(&(bar)[XB_TMO], 1u); break; } } } } while (0)

struct XcdBarrier {
    unsigned* bar; unsigned x;
    volatile LAS unsigned* st;
};

__device__ __forceinline__ XcdBarrier xcd_barrier_post(unsigned* bar, volatile LAS unsigned* st) {
    XcdBarrier b; b.bar = bar; b.x = xb_xcc_id(); b.st = st;
    if (threadIdx.x == 0) (void)xb_add(&bar[XB_XCNT(b.x)], 1u);
    return b;
}
__device__ __forceinline__ void xcd_barrier_complete(unsigned* bar, unsigned x, unsigned& nloc, unsigned& nx) {
    const unsigned G = gridDim.x * gridDim.y * gridDim.z;
    unsigned sum, cnt, mine, sp = 0u;
    for (;;) {
        sum = 0u; cnt = 0u; mine = 0u;
#pragma unroll
        for (unsigned j = 0; j < 16; ++j) { const unsigned c = xb_ld(&bar[XB_XCNT(j)]); sum += c; cnt += (c > 0u) ? 1u : 0u; mine = (j == x) ? c : mine; }
        if (sum == G) break;
        __builtin_amdgcn_s_sleep(1);
        if ((++sp & 255u) == 0u) { if (xb_ld(&bar[XB_TMO])) break; if (sp > XB_SPIN_CAP) { atomicAdd(&bar[XB_TMO], 1u); break; } }
    }
    nloc = mine > 0u ? mine : 1u; nx = cnt > 0u ? cnt : 1u;
}

__device__ __forceinline__ void xcd_barrier(const XcdBarrier& b) {
    asm volatile("s_waitcnt vmcnt(0)" ::: "memory");
    __syncthreads();
    if (threadIdx.x == 0) {
        unsigned* bar = b.bar;
        __builtin_amdgcn_s_waitcnt(0);
        unsigned nloc = b.st[0], nx = b.st[1];
        if (nloc == 0u) { xcd_barrier_complete(bar, b.x, nloc, nx); b.st[0] = nloc; b.st[1] = nx; }
        const unsigned old = xb_add(&bar[XB_XSUB(b.x)], 1u);
        const unsigned gen = old / nloc;
        if (old + 1u == (gen + 1u) * nloc) {
            __builtin_amdgcn_fence(__ATOMIC_RELEASE, "agent");
            asm volatile("s_waitcnt vmcnt(0)" ::: "memory");
            const unsigned og = xb_add(&bar[XB_TOP], 1u);
            const unsigned tg = og / nx;
            if (og + 1u == (tg + 1u) * nx) xb_add(&bar[XB_TOPGEN], 1u);
            else XB_SPIN(xb_ld(&bar[XB_TOPGEN]) == tg, bar);
            __builtin_amdgcn_fence(__ATOMIC_ACQUIRE, "agent");
            xb_add(&bar[XB_XGEN(b.x)], 1u);
            asm volatile("s_waitcnt vmcnt(0)" ::: "memory");
        } else {
            XB_SPIN(xb_ld(&bar[XB_XGEN(b.x)]) == gen, bar);
            __builtin_amdgcn_fence(__ATOMIC_ACQUIRE, "agent");
            asm volatile("s_waitcnt vmcnt(0)" ::: "memory");
        }
    }
    __syncthreads();
}

__global__ void __launch_bounds__(NWAVES * 64, 2) fwd_megakernel(Args args) {
    extern __shared__ __attribute__((aligned(16))) unsigned char lds_raw[];
    LAS unsigned char* lds = (LAS unsigned char*)lds_raw;
    const int tid = threadIdx.x, lane = tid & 63, wave = __builtin_amdgcn_readfirstlane(tid >> 6);
    const int G = gridDim.x; const int bx = blockIdx.x; const int vcu = (G % 8 == 0) ? (bx % 8) * (G / 8) + bx / 8 : bx;
    unsigned char* ws = args.ws;
    const int lo = args.ph_lo, hi = args.ph_hi;
    cg::grid_group grid = cg::this_grid();
    if (lo > 1000) grid.sync();
    volatile LAS unsigned* xst = (volatile LAS unsigned*)(lds + LDS_BYTES - 64);
    if (tid < 2) xst[tid] = 0u;
    __syncthreads();
    const XcdBarrier xbar = xcd_barrier_post((unsigned*)ws, xst);
#ifndef PROBE_K
#define PROBE_K -1
#endif
#ifndef PROBE_NBAR
#define PROBE_NBAR 0
#endif
#define REPS(k) (((k) == PROBE_K) ? 2 : 1)
#define IN(k) (lo <= (k) && (k) < hi)
#define SEAM(k) do { if (IN(k) && IN((k) + 1)) xcd_barrier(xbar); } while (0)
    bf16* XB = (bf16*)(ws + WS_XB); bf16* CAT = (bf16*)(ws + WS_CAT); bf16* H = (bf16*)(ws + WS_H); bf16* HID = (bf16*)(ws + WS_HID);

    if (IN(0)) { p0_prologue(args, lds, vcu, G, tid, wave, lane); __syncthreads(); if (PROBE_K == 0) { xcd_barrier(xbar); p0_prologue(args, lds, vcu, G, tid, wave, lane); __syncthreads(); } }
    SEAM(0);
    if (IN(1)) {
        { pg8::Gemm g{(const bf16*)(ws + WS_MEMB), (const bf16*)(ws + WS_WXK), MEMT, DM, DM}; pg8::StaticOrder S; S.init(MEMT, DM, G, bx);
          pg8::EpiStoreBf16<0> E{(bf16*)(ws + WS_KM), DM};
          pg8::gemm_phase<pg8::EpiStoreBf16<0>, pg8::StaticOrder, true, true>(lds, g, S, E); }
        { pg8::Gemm g{(const bf16*)(ws + WS_WXV), (const bf16*)(ws + WS_MEMB), DM, MEMT, DM}; pg8::StaticOrder S; S.init(DM, MEMT, G, (bx + G - 32) % G);
          pg8::EpiStoreBf16<0> E{(bf16*)(ws + WS_VT), MEMT};
          pg8::gemm_phase<pg8::EpiStoreBf16<0>, pg8::StaticOrder, true, true>(lds, g, S, E); }
        { pg8::Gemm g{XB, (const bf16*)(ws + WS_WIN), T, INC, DM}; pg8::StaticOrder S; S.init(T, INC, G, bx);
          pg8::EpiG1 E{H, (bf16*)(ws + WS_U)};
          pg8::gemm_phase<pg8::EpiG1, pg8::StaticOrder, true, true>(lds, g, S, E); }
        if (PROBE_K == 1) { xcd_barrier(xbar);
        { pg8::Gemm g{XB, (const bf16*)(ws + WS_WIN), T, INC, DM}; pg8::StaticOrder S; S.init(T, INC, G, bx);
          pg8::EpiG1 E{H, (bf16*)(ws + WS_U)};
          pg8::gemm_phase<pg8::EpiG1, pg8::StaticOrder, true, true>(lds, g, S, E); }
        }
    }
    SEAM(1);
    if (IN(2)) { conv_phase(args, lds, vcu, G, tid, wave, lane); ret_kv_phase(args, lds, vcu, G, tid, wave, lane); }
    SEAM(2);
    if (IN(3)) ret_scan_phase(args, vcu, G, tid);
    SEAM(3);
    if (IN(4)) ret_out_phase(args, lds, vcu, G, tid, wave, lane);
    if (PROBE_K == 2) { xcd_barrier(xbar); conv_phase(args, lds, vcu, G, tid, wave, lane); ret_kv_phase(args, lds, vcu, G, tid, wave, lane); xcd_barrier(xbar); ret_scan_phase(args, vcu, G, tid); xcd_barrier(xbar); ret_out_phase(args, lds, vcu, G, tid, wave, lane); }
    if (PROBE_K == 20) { xcd_barrier(xbar); conv_phase(args, lds, vcu, G, tid, wave, lane); }
    if (PROBE_K == 21) { xcd_barrier(xbar); ret_kv_phase(args, lds, vcu, G, tid, wave, lane); }
    if (PROBE_K == 22) { xcd_barrier(xbar); ret_scan_phase(args, vcu, G, tid); }
    if (PROBE_K == 23) { xcd_barrier(xbar); ret_out_phase(args, lds, vcu, G, tid, wave, lane); }
    SEAM(4);
    if (IN(5)) {
        pg8::Gemm g{CAT, (const bf16*)(ws + WS_WOUT), T, DM, DM}; pg8::StaticOrder S; S.init(T, DM, G, bx);
        pg8::EpiResF32 E{args.in[0], args.out, DM, DN_ALPHA};
        pg8::gemm_phase<pg8::EpiResF32, pg8::StaticOrder, true, true>(lds, g, S, E);
        if (PROBE_K == 5) { xcd_barrier(xbar);
        pg8::Gemm g{CAT, (const bf16*)(ws + WS_WOUT), T, DM, DM}; pg8::StaticOrder S; S.init(T, DM, G, bx);
        pg8::EpiResF32 E{args.in[0], args.out, DM, DN_ALPHA};
        pg8::gemm_phase<pg8::EpiResF32, pg8::StaticOrder, true, true>(lds, g, S, E);
        }
    }
    SEAM(5);
    if (IN(6)) ln_phase(args.out, args.in[10], args.in[11], XB, vcu, G, wave, lane);
    SEAM(6);
    if (IN(7)) {
        pg8::Gemm g{XB, (const bf16*)(ws + WS_WXQ), T, DM, DM}; pg8::StaticOrder S; S.init(T, DM, G, bx);
        pg8::EpiStoreBf16<0> E{CAT, DM};
        pg8::gemm_phase<pg8::EpiStoreBf16<0>, pg8::StaticOrder, true, true>(lds, g, S, E);
        if (PROBE_K == 7) { xcd_barrier(xbar);
        pg8::Gemm g{XB, (const bf16*)(ws + WS_WXQ), T, DM, DM}; pg8::StaticOrder S; S.init(T, DM, G, bx);
        pg8::EpiStoreBf16<0> E{CAT, DM};
        pg8::gemm_phase<pg8::EpiStoreBf16<0>, pg8::StaticOrder, true, true>(lds, g, S, E);
        }
    }
    SEAM(7);
    if (IN(8)) { xattn_phase(args, lds, vcu, G, tid, wave, lane); if (PROBE_K == 8) { xcd_barrier(xbar); xattn_phase(args, lds, vcu, G, tid, wave, lane); } }
    SEAM(8);
    if (IN(9)) {
        pg8::Gemm g{XB, (const bf16*)(ws + WS_WXO), T, DM, DM}; pg8::StaticOrder S; S.init(T, DM, G, bx);
        pg8::EpiResF32 E{args.out, args.out, DM, DN_ALPHA};
        pg8::gemm_phase<pg8::EpiResF32, pg8::StaticOrder, true, true>(lds, g, S, E);
    }
    SEAM(9);
    if (IN(10)) ln_phase(args.out, args.in[16], args.in[17], XB, vcu, G, wave, lane);
    SEAM(10);
    if (IN(11)) {
        pg8::Gemm g{XB, (const bf16*)(ws + WS_WUP), T, FF, DM}; pg8::StaticOrder S; S.init(T, FF, G, bx);
        pg8::EpiStoreBf16<1> E{HID, FF};
        pg8::gemm_phase<pg8::EpiStoreBf16<1>, pg8::StaticOrder, true, true>(lds, g, S, E);
        if (PROBE_K == 11) { xcd_barrier(xbar);
        pg8::Gemm g{XB, (const bf16*)(ws + WS_WUP), T, FF, DM}; pg8::StaticOrder S; S.init(T, FF, G, bx);
        pg8::EpiStoreBf16<1> E{HID, FF};
        pg8::gemm_phase<pg8::EpiStoreBf16<1>, pg8::StaticOrder, true, true>(lds, g, S, E);
        }
    }
    SEAM(11);
    if (IN(12)) {
        pg8::Gemm g{HID, (const bf16*)(ws + WS_WDN), T, DM, FF}; pg8::StaticOrder S; S.init(T, DM, G, bx);
        pg8::EpiResF32 E{args.out, args.out, DM, DN_ALPHA};
        pg8::gemm_phase<pg8::EpiResF32, pg8::StaticOrder, true, true>(lds, g, S, E);
    }
    SEAM(12);
    if (IN(13)) ln_phase(args.out, args.in[20], args.in[21], nullptr, vcu, G, wave, lane);
    for (int i_ = 0; i_ < PROBE_NBAR; ++i_) xcd_barrier(xbar);
#undef IN
#undef SEAM
}

#ifndef MK_MULTI
#define MK_MULTI 0
#endif
extern "C" void kernel_launch(void* const* d_in, const int* in_sizes, int n_in, void* d_out, int out_size, void* d_ws, size_t ws_size, hipStream_t stream) {
    static int grid = 0;
    if (grid == 0) {
        if (n_in != 22 || out_size != T * DM || ws_size < WS_END) { fprintf(stderr, "kernel_launch: unexpected problem (n_in %d, out %d, ws %zu)\n", n_in, out_size, ws_size); grid = -1; return; }
        int dev = 0, cus = 0, per_cu = 0;
        if (hipGetDevice(&dev) != hipSuccess || hipDeviceGetAttribute(&cus, hipDeviceAttributeMultiprocessorCount, dev) != hipSuccess) { grid = -1; return; }
        if (hipFuncSetAttribute((const void*)fwd_megakernel, hipFuncAttributeMaxDynamicSharedMemorySize, LDS_BYTES) != hipSuccess) { fprintf(stderr, "kernel_launch: hipFuncSetAttribute failed\n"); grid = -1; return; }
        if (hipOccupancyMaxActiveBlocksPerMultiprocessor(&per_cu, (const void*)fwd_megakernel, NWAVES * 64, LDS_BYTES) != hipSuccess || per_cu < 1) { fprintf(stderr, "kernel_launch: occupancy query gave %d\n", per_cu); (void)hipGetLastError(); per_cu = 1; }
        grid = cus * (per_cu > 1 ? 1 : per_cu);
    }
    if (grid < 0) return;
    if (hipMemsetAsync(d_ws, 0, 16384, stream) != hipSuccess) { fprintf(stderr, "kernel_launch: memset failed\n"); return; }
    Args a{};
    for (int i = 0; i < 22; ++i) a.in[i] = (const float*)d_in[i];
    a.out = (float*)d_out; a.ws = (unsigned char*)d_ws;
#if MK_MULTI
    for (int p = 0; p < NPHASE; ++p) {
        a.ph_lo = p; a.ph_hi = p + 1;
        void* kargs[] = {&a};
        hipError_t e = hipLaunchCooperativeKernel((const void*)fwd_megakernel, dim3(grid), dim3(NWAVES * 64), kargs, LDS_BYTES, stream);
        if (e != hipSuccess) { fprintf(stderr, "kernel_launch: launch of phase %d failed: %s\n", p, hipGetErrorString(e)); break; }
    }
#else
    a.ph_lo = 0; a.ph_hi = NPHASE;
    void* kargs[] = {&a};
    hipError_t e = hipLaunchCooperativeKernel((const void*)fwd_megakernel, dim3(grid), dim3(NWAVES * 64), kargs, LDS_BYTES, stream);
    if (e != hipSuccess) fprintf(stderr, "kernel_launch: cooperative launch failed: %s (grid %d)\n", hipGetErrorString(e), grid);
#endif
}
```
